# Optimizing an MI355X kernel written in HIP

```python
import jax, jax.numpy as jnp
from jax import lax
import numpy as np

D_MODEL = 1024
BATCH = 4
SEQ = 4096
DEPTH = 2

PLE_DIM = 256
D_FF = 2816
LN_EPS = 1e-5
RMS_EPS = 1e-6
DEEPNORM_ALPHA = (2 * DEPTH) ** 0.25
DEEPNORM_BETA = (8 * DEPTH) ** -0.25

GDN_HEADS = 8
GDN_DK = 64
GDN_DV = 64
GDN_CONV = 4
GDN_CHUNK = 64

SB_HEADS = 4
SB_DIM = 64

MLA_HEADS = 4
MLA_NOPE = 64
MLA_ROPE = 32
MLA_V = 64
MLA_Q_RANK = 256
MLA_KV_RANK = 128
ROPE_BASE = 10000.0

Q_BLOCK = 128

MIX_WIDTH = GDN_HEADS * GDN_DV + SB_HEADS * SB_DIM + MLA_HEADS * MLA_V
IN_WIDTHS = (
    GDN_HEADS * GDN_DK, GDN_HEADS * GDN_DK, GDN_HEADS * GDN_DV,
    GDN_HEADS * GDN_DV,
    GDN_HEADS, GDN_HEADS,
    SB_HEADS * SB_DIM, SB_HEADS * SB_DIM, SB_HEADS * SB_DIM,
    MLA_Q_RANK,
    MLA_KV_RANK + MLA_ROPE,
)
IN_TOTAL = int(sum(IN_WIDTHS))
IN_SPLITS = tuple(int(s) for s in np.cumsum(IN_WIDTHS)[:-1])
GDN_CONV_CH = 2 * GDN_HEADS * GDN_DK + GDN_HEADS * GDN_DV

kernel_name = "hybrid_gdn_stickbreak_mla_macaron_deepnorm"


def layer_norm(x, g, b):
    xf = x.astype(jnp.float32)
    mu = jnp.mean(xf, axis=-1, keepdims=True)
    var = jnp.mean(jnp.square(xf - mu), axis=-1, keepdims=True)
    y = (xf - mu) * lax.rsqrt(var + LN_EPS)
    return (y * g.astype(jnp.float32) + b.astype(jnp.float32)).astype(x.dtype)


def rms_norm(x, w):
    xf = x.astype(jnp.float32)
    y = xf * lax.rsqrt(jnp.mean(jnp.square(xf), axis=-1, keepdims=True) + RMS_EPS)
    return (y * w.astype(jnp.float32)).astype(x.dtype)


def l2_normalize(x):
    xf = x.astype(jnp.float32)
    return xf * lax.rsqrt(jnp.sum(jnp.square(xf), axis=-1, keepdims=True) + RMS_EPS)


def swiglu(h, w_in, w_out):
    gate, up = jnp.split(h @ w_in, 2, axis=-1)
    return (jax.nn.silu(gate) * up) @ w_out


def causal_depthwise_conv(x, w):
    k_width, ch = w.shape
    return lax.conv_general_dilated(
        x, w[:, None, :].astype(x.dtype), window_strides=(1,), padding=[(k_width - 1, 0)],
        dimension_numbers=("NWC", "WIO", "NWC"), feature_group_count=ch)


def rope_tables(positions):
    inv = 1.0 / (ROPE_BASE ** (jnp.arange(0, MLA_ROPE, 2, dtype=jnp.float32) / MLA_ROPE))
    ang = positions.astype(jnp.float32)[..., None] * inv
    return jnp.cos(ang), jnp.sin(ang)


def apply_rope(x, cos, sin):
    x1, x2 = jnp.split(x.astype(jnp.float32), 2, axis=-1)
    return jnp.concatenate([x1 * cos - x2 * sin, x2 * cos + x1 * sin], axis=-1).astype(x.dtype)


def chunk_gated_delta_rule(q, k, v, g, beta):
    B, S, H, DK = q.shape
    DV = v.shape[-1]
    C = GDN_CHUNK
    N = S // C
    f32 = jnp.float32

    def chunks(t):
        t = t.astype(f32).reshape((B, N, C) + t.shape[2:])
        return jnp.moveaxis(jnp.moveaxis(t, 3, 2), 1, 0)

    qc, kc, vc, gc, bc = (chunks(t) for t in (q, k, v, g, beta))
    gc = jnp.cumsum(gc, axis=-1)
    incl = jnp.tril(jnp.ones((C, C), dtype=bool))
    strict = jnp.tril(jnp.ones((C, C), dtype=bool), -1)
    diff = gc[..., :, None] - gc[..., None, :]
    decay = jnp.where(incl, jnp.exp(jnp.where(incl, diff, 0.0)), 0.0)
    kb = kc * bc[..., None]
    lhs = jnp.where(strict, jnp.einsum('nbhid,nbhjd->nbhij', kb, kc) * decay, 0.0) + jnp.eye(C, dtype=f32)
    u = lax.linalg.triangular_solve(lhs, vc * bc[..., None], left_side=True, lower=True, unit_diagonal=True)
    w = lax.linalg.triangular_solve(lhs, kb * jnp.exp(gc)[..., None], left_side=True, lower=True, unit_diagonal=True)
    qk = jnp.where(incl, jnp.einsum('nbhid,nbhjd->nbhij', qc, kc) * decay, 0.0)
    q_dec = qc * jnp.exp(gc)[..., None]
    k_dec = kc * jnp.exp(gc[..., -1:] - gc)[..., None]
    g_last = jnp.exp(gc[..., -1])

    def step(state, xs):
        u_n, w_n, qk_n, qd_n, kd_n, gl_n = xs
        v_new = u_n - jnp.einsum('bhck,bhkv->bhcv', w_n, state)
        o_n = jnp.einsum('bhck,bhkv->bhcv', qd_n, state) + jnp.einsum('bhij,bhjv->bhiv', qk_n, v_new)
        state = state * gl_n[..., None, None] + jnp.einsum('bhck,bhcv->bhkv', kd_n, v_new)
        return state, o_n

    s0 = jnp.zeros((B, H, DK, DV), f32)
    _, o = lax.scan(step, s0, (u, w, qk, q_dec, k_dec, g_last))
    return jnp.transpose(o, (1, 0, 3, 2, 4)).reshape(B, S, H, DV)


def gated_deltanet(gq, gk, gv, gz, ga, gb, conv_w, a_log, dt_bias, norm_w):
    B, S, _ = gq.shape
    f32 = jnp.float32
    qkv = jax.nn.silu(causal_depthwise_conv(jnp.concatenate([gq, gk, gv], axis=-1), conv_w))
    q, k, v = jnp.split(qkv, [GDN_HEADS * GDN_DK, 2 * GDN_HEADS * GDN_DK], axis=-1)
    q = l2_normalize(q.reshape(B, S, GDN_HEADS, GDN_DK)) * (GDN_DK ** -0.5)
    k = l2_normalize(k.reshape(B, S, GDN_HEADS, GDN_DK))
    v = v.reshape(B, S, GDN_HEADS, GDN_DV)
    beta = jax.nn.sigmoid(gb.astype(f32))
    g = -jnp.exp(a_log.astype(f32)) * jax.nn.softplus(ga.astype(f32) + dt_bias.astype(f32))
    o = chunk_gated_delta_rule(q, k, v, g, beta)
    o = rms_norm(o, norm_w) * jax.nn.silu(gz.reshape(B, S, GDN_HEADS, GDN_DV).astype(f32))
    return o.reshape(B, S, GDN_HEADS * GDN_DV).astype(gq.dtype)


def to_query_blocks(t):
    B, S = t.shape[:2]
    return jnp.swapaxes(t.reshape((B, S // Q_BLOCK, Q_BLOCK) + t.shape[2:]), 0, 1)


def from_query_blocks(t):
    t = jnp.swapaxes(t, 0, 1)
    return t.reshape((t.shape[0], t.shape[1] * t.shape[2]) + t.shape[3:])


def stick_breaking_attention(q, k, v):
    S = q.shape[1]
    scale = SB_DIM ** -0.5
    kpos = jnp.arange(S)

    def block(args):
        qb, i = args
        z = jnp.einsum('bqhd,bkhd->bhqk', qb, k).astype(jnp.float32) * scale
        qpos = i * Q_BLOCK + jnp.arange(Q_BLOCK)
        mask = kpos[None, :] < qpos[:, None]
        log_1m = jnp.where(mask, jax.nn.log_sigmoid(-z), 0.0)
        rest = lax.cumsum(log_1m, axis=3, reverse=True) - log_1m
        wts = jnp.where(mask, jnp.exp(jax.nn.log_sigmoid(z) + rest), 0.0)
        return jnp.einsum('bhqk,bkhd->bqhd', wts.astype(v.dtype), v)

    nb = S // Q_BLOCK
    out = lax.map(block, (to_query_blocks(q), jnp.arange(nb)))
    return from_query_blocks(out)


def mla_attention(q_nope, q_rope, k_nope, k_rope, v):
    S = q_nope.shape[1]
    scale = (MLA_NOPE + MLA_ROPE) ** -0.5
    kpos = jnp.arange(S)

    def block(args):
        qn, qr, i = args
        s = (jnp.einsum('bqhd,bkhd->bhqk', qn, k_nope) + jnp.einsum('bqhd,bkd->bhqk', qr, k_rope)).astype(jnp.float32) * scale
        qpos = i * Q_BLOCK + jnp.arange(Q_BLOCK)
        s = jnp.where(kpos[None, :] <= qpos[:, None], s, -jnp.inf)
        pr = jax.nn.softmax(s, axis=-1)
        return jnp.einsum('bhqk,bkhd->bqhd', pr.astype(v.dtype), v)

    nb = S // Q_BLOCK
    out = lax.map(block, (to_query_blocks(q_nope), to_query_blocks(q_rope), jnp.arange(nb)))
    return from_query_blocks(out)


def hybrid_mixer(h, cos, sin, w_in, conv_w, a_log, dt_bias, gdn_norm_w, q_norm_w, kv_norm_w, w_uq, w_ukv, w_o):
    B, S, _ = h.shape
    proj = h @ w_in
    gq, gk, gv, gz, ga, gb, sq, sk, sv, mq, mkv = jnp.split(proj, IN_SPLITS, axis=-1)
    o_gdn = gated_deltanet(gq, gk, gv, gz, ga, gb, conv_w, a_log, dt_bias, gdn_norm_w)
    shp = (B, S, SB_HEADS, SB_DIM)
    o_sb = stick_breaking_attention(sq.reshape(shp), sk.reshape(shp), sv.reshape(shp)).reshape(B, S, SB_HEADS * SB_DIM)
    qf = (rms_norm(mq, q_norm_w) @ w_uq).reshape(B, S, MLA_HEADS, MLA_NOPE + MLA_ROPE)
    q_nope, q_rope = jnp.split(qf, [MLA_NOPE], axis=-1)
    ckv, k_rope = jnp.split(mkv, [MLA_KV_RANK], axis=-1)
    kvf = (rms_norm(ckv, kv_norm_w) @ w_ukv).reshape(B, S, MLA_HEADS, MLA_NOPE + MLA_V)
    k_nope, v_mla = jnp.split(kvf, [MLA_NOPE], axis=-1)
    q_rope = apply_rope(q_rope, cos[:, :, None, :], sin[:, :, None, :])
    k_rope = apply_rope(k_rope, cos, sin)
    o_mla = mla_attention(q_nope, q_rope, k_nope, k_rope, v_mla).reshape(B, S, MLA_HEADS * MLA_V)
    return jnp.concatenate([o_gdn, o_sb, o_mla], axis=-1) @ w_o


def setup_inputs(seed: int = 0) -> dict:
    key = jax.random.key(seed)
    ks = jax.random.split(key, 24)
    f32 = jnp.float32
    L = DEPTH

    def nrm(k, shape, scale):
        return jax.random.normal(k, shape, f32) * scale

    x = nrm(ks[0], (BATCH, SEQ, D_MODEL), 1.0)
    p = nrm(ks[1], (DEPTH, BATCH, SEQ, PLE_DIM), 1.0)
    positions = (jnp.arange(SEQ, dtype=jnp.int32)[None, :]
                 + jax.random.randint(ks[2], (BATCH, 1), 0, 1024, dtype=jnp.int32))
    a_init = jax.random.uniform(ks[7], (L, GDN_HEADS), f32, 1.0, 16.0)
    dt = jnp.exp(jax.random.uniform(ks[8], (L, GDN_HEADS), f32, np.log(1e-3), np.log(1e-1)))
    return {
        "x": x,
        "p": p,
        "positions": positions,
        "ffa_w_in": nrm(ks[3], (L, D_MODEL, 2 * D_FF), D_MODEL ** -0.5),
        "ffa_w_out": nrm(ks[4], (L, D_FF, D_MODEL), D_FF ** -0.5 * DEEPNORM_BETA),
        "mix_w_in": nrm(ks[5], (L, D_MODEL, IN_TOTAL), D_MODEL ** -0.5),
        "gdn_conv_w": nrm(ks[6], (L, GDN_CONV, GDN_CONV_CH), GDN_CONV ** -0.5),
        "gdn_a_log": jnp.log(a_init),
        "gdn_dt_bias": dt + jnp.log(-jnp.expm1(-dt)),
        "gdn_norm_w": 1.0 + nrm(ks[9], (L, GDN_DV), 0.02),
        "mla_q_norm_w": 1.0 + nrm(ks[10], (L, MLA_Q_RANK), 0.02),
        "mla_kv_norm_w": 1.0 + nrm(ks[11], (L, MLA_KV_RANK), 0.02),
        "mla_w_uq": nrm(ks[12], (L, MLA_Q_RANK, MLA_HEADS * (MLA_NOPE + MLA_ROPE)), MLA_Q_RANK ** -0.5),
        "mla_w_ukv": nrm(ks[13], (L, MLA_KV_RANK, MLA_HEADS * (MLA_NOPE + MLA_V)), MLA_KV_RANK ** -0.5),
        "mix_w_o": nrm(ks[14], (L, MIX_WIDTH, D_MODEL), MIX_WIDTH ** -0.5 * DEEPNORM_BETA),
        "ffb_w_in": nrm(ks[15], (L, D_MODEL, 2 * D_FF), D_MODEL ** -0.5),
        "ffb_w_out": nrm(ks[16], (L, D_FF, D_MODEL), D_FF ** -0.5 * DEEPNORM_BETA),
        "ln_g": 1.0 + nrm(ks[17], (L, 3, D_MODEL), 0.02),
        "ln_b": nrm(ks[18], (L, 3, D_MODEL), 0.02),
        "ple_w_gate": nrm(ks[19], (L, D_MODEL, D_MODEL), D_MODEL ** -0.5),
        "ple_w_proj": nrm(ks[20], (L, PLE_DIM, D_MODEL), PLE_DIM ** -0.5 * DEEPNORM_BETA),
    }


def reference(x, p, positions, ffa_w_in, ffa_w_out, mix_w_in, gdn_conv_w, gdn_a_log, gdn_dt_bias,
              gdn_norm_w, mla_q_norm_w, mla_kv_norm_w, mla_w_uq, mla_w_ukv, mix_w_o,
              ffb_w_in, ffb_w_out, ln_g, ln_b, ple_w_gate, ple_w_proj):
    cos, sin = rope_tables(positions)
    h = x
    for i in range(DEPTH):
        h = layer_norm(DEEPNORM_ALPHA * h + 0.5 * swiglu(h, ffa_w_in[i], ffa_w_out[i]), ln_g[i, 0], ln_b[i, 0])
        mix = hybrid_mixer(h, cos, sin, mix_w_in[i], gdn_conv_w[i], gdn_a_log[i], gdn_dt_bias[i], gdn_norm_w[i],
                           mla_q_norm_w[i], mla_kv_norm_w[i], mla_w_uq[i], mla_w_ukv[i], mix_w_o[i])
        h = layer_norm(DEEPNORM_ALPHA * h + mix, ln_g[i, 1], ln_b[i, 1])
        h = layer_norm(DEEPNORM_ALPHA * h + 0.5 * swiglu(h, ffb_w_in[i], ffb_w_out[i]), ln_g[i, 2], ln_b[i, 2])
        h = h + jax.nn.sigmoid(h @ ple_w_gate[i]) * (p[i] @ ple_w_proj[i])
    return h
```

```cpp
#include <hip/hip_runtime.h>
#include <hip/hip_cooperative_groups.h>
#include <cstdio>
#include <cstdint>
namespace cg = cooperative_groups;

#ifndef MK_ONE_LAUNCH
#define MK_ONE_LAUNCH 1
#endif

#define LAS __attribute__((address_space(3)))
#define DI __device__ __forceinline__
typedef unsigned short bf16_t;
typedef short bf16x8 __attribute__((ext_vector_type(8)));
typedef float f32x4 __attribute__((ext_vector_type(4)));
typedef float f32x2 __attribute__((ext_vector_type(2)));
typedef float f32x16 __attribute__((ext_vector_type(16)));
typedef unsigned u32x4 __attribute__((ext_vector_type(4)));
typedef unsigned u32x2 __attribute__((ext_vector_type(2)));

DI unsigned pk2(float lo, float hi) { typedef __bf16 b2 __attribute__((ext_vector_type(2))); f32x2 v = {lo, hi}; b2 b = __builtin_convertvector(v, b2); return __builtin_bit_cast(unsigned, b); }
DI float bflo(unsigned w) { return __uint_as_float(w << 16); }
DI float bfhi(unsigned w) { return __uint_as_float(w & 0xffff0000u); }
DI float bf2f(bf16_t u) { return __uint_as_float(((unsigned)u) << 16); }
DI bf16_t f2bf(float f) { return (bf16_t)(pk2(f, 0.f) & 0xffffu); }
DI float wave_sum(float v) {
#pragma unroll
    for (int o = 1; o < 64; o <<= 1) v += __shfl_xor(v, o);
    return v;
}
DI float fexp2(float x) { return __builtin_amdgcn_exp2f(x); }
DI float flog2(float x) { return __builtin_amdgcn_logf(x); }
DI float frcp(float x) { return __builtin_amdgcn_rcpf(x); }
DI float silu_f(float g) { return g * frcp(1.f + fexp2(-1.4426950408889634f * g)); }
DI float sigmoid_f(float g) { return frcp(1.f + fexp2(-1.4426950408889634f * g)); }
#define LBAR() do { asm volatile("s_waitcnt lgkmcnt(0)" ::: "memory"); __builtin_amdgcn_s_barrier(); asm volatile("" ::: "memory"); } while (0)
DI float half_sum(float v) { const unsigned u = __float_as_uint(v); auto rr = __builtin_amdgcn_permlane32_swap(u, u, false, false); return __uint_as_float(rr[0]) + __uint_as_float(rr[1]); }
DI float half_max(float v) { const unsigned u = __float_as_uint(v); auto rr = __builtin_amdgcn_permlane32_swap(u, u, false, false); return fmaxf(__uint_as_float(rr[0]), __uint_as_float(rr[1])); }
DI int crow(int r, int hi) { return (r & 3) + 8 * (r >> 2) + 4 * hi; }
#define MFMA32(a, b, c) __builtin_amdgcn_mfma_f32_32x32x16_bf16((a), (b), (c), 0, 0, 0)
#define MFMA16(a, b, c) __builtin_amdgcn_mfma_f32_16x16x32_bf16((a), (b), (c), 0, 0, 0)
DI bf16x8 pack8(const f32x16& x, int s) {
    u32x4 p;
    p.x = pk2(x[8 * s + 0], x[8 * s + 1]); p.y = pk2(x[8 * s + 2], x[8 * s + 3]); p.z = pk2(x[8 * s + 4], x[8 * s + 5]); p.w = pk2(x[8 * s + 6], x[8 * s + 7]);
    return __builtin_bit_cast(bf16x8, p);
}

constexpr int T_ = 16384, DM = 1024, SEQ = 4096, DFF = 2816, NIN = 3248, NINP = 3328;
constexpr float ALPHA = 1.4142135623730951f;
constexpr float LN_EPS = 1e-5f;
constexpr int C_GZ = 1536, C_GA = 2048, C_GB = 2056, C_SQ = 2064, C_SK = 2320, C_SV = 2576, C_MQ = 2832, C_CKV = 3088, C_KR = 3216;
constexpr size_t MiB = 1u << 20;
constexpr size_t WS_CTL = 0, WS_GL = 65536, WS_ROPE = 1 * MiB, WS_W = 3 * MiB, WS_AB = 48 * MiB, WS_G = 152 * MiB, WS_MQ = 232 * MiB, WS_MK = 244 * MiB, WS_MVT = 256 * MiB, WS_SVT = 264 * MiB, WS_END = 272 * MiB;
constexpr size_t WS_HB1 = WS_G + 32 * MiB, WS_PB = WS_AB + 96 * MiB;
constexpr size_t OW_A1 = 0, OW_A2 = 5767168, OW_B1 = 8650752, OW_B2 = 14417920, OW_MI = 17301504, OW_UQ = 20709376, OW_UKV = 20807680, OW_O = 20873216, OW_GT = 21921792, OW_P = 22970368;
constexpr int LDS_BYTES = 147456;
constexpr int GSLOT = 40960;

namespace pg8 {
constexpr int BM = 256, BK = 64, HALF = 128, HTB = HALF * BK * 2, STAGE_BYTES = 8 * HTB, NXCD = 8, WGM = 8;
DI int lds_byte(int r, int c) { const int st = (r >> 4) * 2 + (c >> 5), rr = r & 15, cc = c & 31, ob = rr * 64 + cc * 2; return st * 1024 + (ob ^ (((ob >> 9) & 1) << 5)); }
DI void stage_rc(int b, int& R, int& C) { const int st = b / 1024, sb = b % 1024, swz = sb ^ (((sb >> 9) & 1) << 5); R = (st >> 1) * 16 + swz / 64; C = (st & 1) * 32 + (swz % 64) / 2; }
DI int perm32(int rho) { const int n = rho >> 4, i = rho & 15; return 8 * (i >> 2) + 4 * n + (i & 3); }
struct Unit { int pm, pn; };
struct Gemm { const bf16_t* A; const bf16_t* Bt; int M, N, K, lda; };
struct StaticOrder {
    int nM, nN, nwg, G, c;
    DI void init(int M, int N, int G_, int c_) { nM = M / BM; nN = N / BM; nwg = nM * nN; G = G_; c = c_; }
    DI bool next(int i, Unit& u) const {
        const long L = (long)i * G + c; if (L >= nwg) return false;
        int wgid = (int)L; { const int q = nwg / NXCD, r = nwg % NXCD, xcd = wgid % NXCD, off = wgid / NXCD; wgid = (xcd < r ? xcd * (q + 1) : r * (q + 1) + (xcd - r) * q) + off; }
        const int nig = WGM * nN, gid = wgid / nig, fm = gid * WGM, gsz = (nM - fm) < WGM ? (nM - fm) : WGM;
        u.pm = fm + ((wgid % nig) % gsz); u.pn = (wgid % nig) / gsz; return true;
    }
};
struct EpiBf16 {
    static constexpr bool PERM = true, AFTER_DRAIN = false;
    bf16_t* O; int ldc;
    DI void operator()(const f32x4 (&acc)[2][2][4][2], const Unit& u, int wr, int wc, int fr, int fq) const {
        const int row0 = u.pm * BM + wr * 64 + fr; const int col0 = u.pn * BM + wc * 32 + 8 * fq;
#pragma unroll
        for (int ai = 0; ai < 2; ++ai)
#pragma unroll
            for (int m = 0; m < 4; ++m) { bf16_t* rowp = O + (size_t)(row0 + ai * HALF + m * 16) * ldc + col0;
#pragma unroll
                for (int bj = 0; bj < 2; ++bj) { const f32x4 v0 = acc[ai][bj][m][0], v1 = acc[ai][bj][m][1];
                    u32x4 w; w.x = pk2(v0[0], v0[1]); w.y = pk2(v0[2], v0[3]); w.z = pk2(v1[0], v1[1]); w.w = pk2(v1[2], v1[3]);
                    *(u32x4*)(rowp + bj * HALF) = w; } }
    }
};
struct EpiSwiGLU {
    static constexpr bool PERM = true, AFTER_DRAIN = false;
    bf16_t* O; int ldc;
    DI void operator()(const f32x4 (&acc)[2][2][4][2], const Unit& u, int wr, int wc, int fr, int fq) const {
        const int row0 = u.pm * BM + wr * 64 + fr; const int col0 = u.pn * HALF + wc * 32 + 8 * fq;
#pragma unroll
        for (int ai = 0; ai < 2; ++ai)
#pragma unroll
            for (int m = 0; m < 4; ++m) { bf16_t* rowp = O + (size_t)(row0 + ai * HALF + m * 16) * ldc + col0;
                float v[8];
#pragma unroll
                for (int n = 0; n < 2; ++n)
#pragma unroll
                    for (int e = 0; e < 4; ++e) v[4 * n + e] = silu_f(acc[ai][0][m][n][e]) * acc[ai][1][m][n][e];
                u32x4 w; w.x = pk2(v[0], v[1]); w.y = pk2(v[2], v[3]); w.z = pk2(v[4], v[5]); w.w = pk2(v[6], v[7]);
                *(u32x4*)rowp = w; }
    }
};
struct EpiResid {
    static constexpr bool PERM = false, AFTER_DRAIN = false;
    const float* Hin; float* H; int ldc; float alpha, s;
    DI void operator()(const f32x4 (&acc)[2][2][4][2], const Unit& u, int wr, int wc, int fr, int fq) const {
        const int col0 = u.pn * BM + wc * 32 + 4 * fq;
#pragma unroll
        for (int ai = 0; ai < 2; ++ai)
#pragma unroll
            for (int m = 0; m < 4; ++m) { const int r = u.pm * BM + ai * HALF + wr * 64 + m * 16 + fr; const size_t ro = (size_t)r * ldc + col0;
#pragma unroll
                for (int bj = 0; bj < 2; ++bj)
#pragma unroll
                    for (int n = 0; n < 2; ++n) { const f32x4 h = *(const f32x4*)(Hin + ro + bj * HALF + n * 16); *(f32x4*)(H + ro + bj * HALF + n * 16) = h * alpha + acc[ai][bj][m][n] * s; } }
    }
};
struct EpiPle {
    static constexpr bool PERM = false, AFTER_DRAIN = false;
    float* H; const bf16_t* PP; bf16_t* HB; int ldc;
    DI void operator()(const f32x4 (&acc)[2][2][4][2], const Unit& u, int wr, int wc, int fr, int fq) const {
        const int col0 = u.pn * BM + wc * 32 + 4 * fq;
#pragma unroll
        for (int ai = 0; ai < 2; ++ai)
#pragma unroll
            for (int m = 0; m < 4; ++m) { const int r = u.pm * BM + ai * HALF + wr * 64 + m * 16 + fr; const size_t ro = (size_t)r * ldc + col0;
#pragma unroll
                for (int bj = 0; bj < 2; ++bj)
#pragma unroll
                    for (int n = 0; n < 2; ++n) { const size_t off = ro + bj * HALF + n * 16; f32x4* p = (f32x4*)(H + off); const f32x4 h = *p; const u32x2 pw = *(const u32x2*)(PP + off);
                        const f32x4 a = acc[ai][bj][m][n]; f32x4 o;
                        o[0] = h[0] + sigmoid_f(a[0]) * bflo(pw.x); o[1] = h[1] + sigmoid_f(a[1]) * bfhi(pw.x); o[2] = h[2] + sigmoid_f(a[2]) * bflo(pw.y); o[3] = h[3] + sigmoid_f(a[3]) * bfhi(pw.y);
                        *p = o; u32x2 w; w.x = pk2(o[0], o[1]); w.y = pk2(o[2], o[3]); *(u32x2*)(HB + off) = w; } }
    }
};

struct EpiResidLn {
    static constexpr bool PERM = false, AFTER_DRAIN = true;
    const float* Hin; float* H; bf16_t* HB; int ldc; float alpha, s; const float* g; const float* b;
    unsigned long long* xbuf; unsigned* cnt;
    DI void fused(f32x4 (&acc)[2][2][4][2], const Unit& u, int wr, int wc, int fr_, int fq_, LAS unsigned char* lds, int wid, int lane_) const {
        int lane = lane_; asm volatile("" : "+v"(lane));
        const int fr = lane & 15, fq = lane >> 4;
        LAS f32x2* P = (LAS f32x2*)lds;
        LAS f32x2* S = (LAS f32x2*)(lds + 8192);
        const int col0 = u.pn * BM + wc * 32 + 4 * fq;
#pragma unroll
        for (int ai = 0; ai < 2; ++ai)
#pragma unroll
            for (int m = 0; m < 4; ++m) { const int r = u.pm * BM + ai * HALF + wr * 64 + m * 16 + fr; const size_t ro = (size_t)r * ldc + col0;
#pragma unroll
                for (int bj = 0; bj < 2; ++bj)
#pragma unroll
                    for (int n = 0; n < 2; ++n) { const f32x4 h = *(const f32x4*)(Hin + ro + bj * HALF + n * 16); acc[ai][bj][m][n] = h * alpha + acc[ai][bj][m][n] * s; }
                asm volatile("" : "+v"(acc[ai][0][m][0]), "+v"(acc[ai][0][m][1]), "+v"(acc[ai][1][m][0]), "+v"(acc[ai][1][m][1]));
                asm volatile("" ::: "memory"); }
#pragma unroll
        for (int ai = 0; ai < 2; ++ai)
#pragma unroll
            for (int m = 0; m < 4; ++m) {
                float sm = 0.f;
#pragma unroll
                for (int bj = 0; bj < 2; ++bj)
#pragma unroll
                    for (int n = 0; n < 2; ++n) { const f32x4 x = acc[ai][bj][m][n]; sm += (x[0] + x[1]) + (x[2] + x[3]); }
                sm += __shfl_xor(sm, 16); sm += __shfl_xor(sm, 32);
                const float mw = sm * (1.0f / 64.0f); float q = 0.f;
#pragma unroll
                for (int bj = 0; bj < 2; ++bj)
#pragma unroll
                    for (int n = 0; n < 2; ++n) { const f32x4 d = acc[ai][bj][m][n] - mw; q += (d[0] * d[0] + d[1] * d[1]) + (d[2] * d[2] + d[3] * d[3]); }
                q += __shfl_xor(q, 16); q += __shfl_xor(q, 32);
                if (fq == 0) P[(ai * HALF + wr * 64 + m * 16 + fr) * 4 + wc] = (f32x2){mw, q};
                __builtin_amdgcn_sched_barrier(0);
            }
        asm volatile("s_waitcnt lgkmcnt(0)" ::: "memory"); __builtin_amdgcn_s_barrier(); asm volatile("" ::: "memory");
        const int row = wid * 32 + (lane & 31);
        if (lane < 32) {
            const f32x2 a = P[row * 4 + 0], bb = P[row * 4 + 1], cc = P[row * 4 + 2], dd = P[row * 4 + 3];
            const float mt = (a[0] + bb[0] + cc[0] + dd[0]) * 0.25f;
            const float da = a[0] - mt, db = bb[0] - mt, dc = cc[0] - mt, de = dd[0] - mt;
            const float m2 = (a[1] + bb[1]) + (cc[1] + dd[1]) + 64.0f * ((da * da + db * db) + (dc * dc + de * de));
            unsigned long long* slot = xbuf + ((size_t)(u.pm * BM + row) * 4 + u.pn);
            __hip_atomic_store(slot, ((unsigned long long)__float_as_uint(m2) << 32) | __float_as_uint(mt), __ATOMIC_RELAXED, __HIP_MEMORY_SCOPE_AGENT);
        }
        asm volatile("s_waitcnt vmcnt(0)" ::: "memory");
        if (lane == 0) __hip_atomic_fetch_add(cnt + 64 * u.pm, 1u, __ATOMIC_RELAXED, __HIP_MEMORY_SCOPE_AGENT);
        if (wid == 0) {
            unsigned spins = 0;
            while ((unsigned)__builtin_amdgcn_readfirstlane(__hip_atomic_load(cnt + 64 * u.pm, __ATOMIC_RELAXED, __HIP_MEMORY_SCOPE_AGENT)) < 32u) { __builtin_amdgcn_s_sleep(2); if (++spins > (1u << 22)) break; }
            __builtin_amdgcn_fence(__ATOMIC_ACQUIRE, "agent");
        }
        asm volatile("s_waitcnt vmcnt(0) lgkmcnt(0)" ::: "memory"); __builtin_amdgcn_s_barrier(); asm volatile("" ::: "memory");
        if (lane < 32) {
            const unsigned long long* slot = xbuf + (size_t)(u.pm * BM + row) * 4; float mt[4], m2[4]; float ms = 0.f;
#pragma unroll
            for (int t = 0; t < 4; ++t) { const unsigned long long w = __hip_atomic_load(slot + t, __ATOMIC_RELAXED, __HIP_MEMORY_SCOPE_AGENT); mt[t] = __uint_as_float((unsigned)w); m2[t] = __uint_as_float((unsigned)(w >> 32)); ms += mt[t]; }
            const float mean = ms * 0.25f; float q = 0.f;
#pragma unroll
            for (int t = 0; t < 4; ++t) { const float dm = mt[t] - mean; q += m2[t] + 256.0f * dm * dm; }
            S[row] = (f32x2){mean, __builtin_amdgcn_rsqf(q * (1.0f / 1024.0f) + LN_EPS)};
        }
        asm volatile("s_waitcnt lgkmcnt(0)" ::: "memory"); __builtin_amdgcn_s_barrier(); asm volatile("" ::: "memory");
#pragma unroll
        for (int ai = 0; ai < 2; ++ai)
#pragma unroll
            for (int m = 0; m < 4; ++m) { const int rl = ai * HALF + wr * 64 + m * 16 + fr; const f32x2 sr = S[rl]; const size_t ro = (size_t)(u.pm * BM + rl) * ldc + col0;
#pragma unroll
                for (int bj = 0; bj < 2; ++bj)
#pragma unroll
                    for (int n = 0; n < 2; ++n) { const f32x4 gv = *(const f32x4*)(g + col0 + bj * HALF + n * 16), bv = *(const f32x4*)(b + col0 + bj * HALF + n * 16);
                        const f32x4 o = (acc[ai][bj][m][n] - sr[0]) * sr[1] * gv + bv;
                        *(f32x4*)(H + ro + bj * HALF + n * 16) = o; u32x2 w; w.x = pk2(o[0], o[1]); w.y = pk2(o[2], o[3]); *(u32x2*)(HB + ro + bj * HALF + n * 16) = w; }
                __builtin_amdgcn_sched_barrier(0); }
    }
};

template <class Epi, class Sched, bool ALIGN_EPI>
DI void gemm_phase(LAS unsigned char* lds, const Gemm g, const Sched& S, const Epi& E) {
    const int tid = threadIdx.x, wid = __builtin_amdgcn_readfirstlane(tid >> 6), lane = tid & 63, wr = wid >> 2, wc = wid & 3, fr = lane & 15, fq = lane >> 4;
    const int K = g.K, nt = K / BK, lda = g.lda;
    unsigned voffA[2], voffB[2];
#pragma unroll
    for (int i = 0; i < 2; ++i) { int R, C; stage_rc(tid * 16 + i * 8192, R, C); const int Rb = Epi::PERM ? ((R & ~31) + perm32(R & 31)) : R;
        voffA[i] = (unsigned)(R * lda + C) * 2u; voffB[i] = (unsigned)(Rb * K + C) * 2u; }
    const size_t kstep = (size_t)(BK * 2);
    const size_t hstepA = (size_t)HALF * lda * 2, tstepA = 2 * hstepA;
    const size_t hstepB = (size_t)HALF * K * 2, tstepB = 2 * hstepB;
    const unsigned ldsw = (unsigned)wid * 1024u;
    const int aoff = lds_byte(wr * 64 + fr, fq * 8), boff = lds_byte(wc * 32 + fr, fq * 8);
#define PG8_SA(b, h) (((b) * 2 + (h)) * HTB)
#define PG8_SB(b, h) ((4 + (b) * 2 + (h)) * HTB)
#define PG8_STAGE(bufoff, gbase, voff) do { _Pragma("unroll") for (int _i = 0; _i < 2; ++_i) \
        __builtin_amdgcn_global_load_lds((const unsigned*)((const char*)(gbase) + (voff)[_i]), (LAS unsigned*)(lds + (bufoff) + ldsw + _i * 8192), 16, 0, 0); } while (0)
#define PG8_LDA(dst, b, h) do { _Pragma("unroll") for (int m = 0; m < 4; ++m) _Pragma("unroll") for (int k = 0; k < 2; ++k) dst[m][k] = *(const LAS bf16x8*)(lds + PG8_SA(b, h) + aoff + m * 2048 + k * 1024); } while (0)
#define PG8_LDB(dst, b, h) do { _Pragma("unroll") for (int n = 0; n < 2; ++n) _Pragma("unroll") for (int k = 0; k < 2; ++k) dst[n][k] = *(const LAS bf16x8*)(lds + PG8_SB(b, h) + boff + n * 2048 + k * 1024); } while (0)
#define PG8_MMA(ai, bj, At, Bt) do { __builtin_amdgcn_s_setprio(1); _Pragma("unroll") for (int m = 0; m < 4; ++m) _Pragma("unroll") for (int n = 0; n < 2; ++n) _Pragma("unroll") for (int k = 0; k < 2; ++k) \
        acc[ai][bj][m][n] = __builtin_amdgcn_mfma_f32_16x16x32_bf16(Bt[n][k], At[m][k], acc[ai][bj][m][n], 0, 0, 0); __builtin_amdgcn_s_setprio(0); } while (0)
#define PG8_WAIT_V(n) asm volatile("s_waitcnt vmcnt(" #n ")" ::: "memory")
#define PG8_WAIT_L(n) asm volatile("s_waitcnt lgkmcnt(" #n ")" ::: "memory")
#define PG8_BAR __builtin_amdgcn_s_barrier()
#define PG8_SCHED __builtin_amdgcn_sched_barrier(0)
    Unit cur, nxt; int ui = 0;
    if (!S.next(0, cur)) return;
    f32x4 acc[2][2][4][2];
#pragma unroll
    for (int a = 0; a < 2; ++a)
#pragma unroll
        for (int b = 0; b < 2; ++b)
#pragma unroll
            for (int m = 0; m < 4; ++m)
#pragma unroll
                for (int n = 0; n < 2; ++n) acc[a][b][m][n] = (f32x4){0.f, 0.f, 0.f, 0.f};
    bf16x8 At[4][2], B0[2][2], B1[2][2];
    const char* cA = (const char*)g.A + (size_t)cur.pm * tstepA; const char* cB = (const char*)g.Bt + (size_t)cur.pn * tstepB;
    PG8_STAGE(PG8_SB(0, 0), cB, voffB); PG8_STAGE(PG8_SB(0, 1), cB + hstepB, voffB); PG8_STAGE(PG8_SA(0, 0), cA, voffA); PG8_STAGE(PG8_SA(0, 1), cA + hstepA, voffA);
    if (wr == 1) PG8_BAR;
    PG8_WAIT_V(2); PG8_BAR;
    PG8_STAGE(PG8_SB(1, 0), cB + kstep, voffB); PG8_STAGE(PG8_SA(1, 0), cA + kstep, voffA); PG8_STAGE(PG8_SB(1, 1), cB + hstepB + kstep, voffB);
    PG8_WAIT_V(6); PG8_BAR;
    for (;;) {
        const bool has_next = S.next(ui + 1, nxt);
        const char* nA = has_next ? (const char*)g.A + (size_t)nxt.pm * tstepA : cA; const char* nB = has_next ? (const char*)g.Bt + (size_t)nxt.pn * tstepB : cB;
        for (int t = 0; t < nt; t += 2) {
            const bool last = (t == nt - 2);
            const char* a1 = cA + (size_t)(t + 1) * kstep;
            const char* a2 = last ? nA : cA + (size_t)(t + 2) * kstep; const char* b2 = last ? nB : cB + (size_t)(t + 2) * kstep;
            const char* a3 = a2 + kstep; const char* b3 = b2 + kstep;
            PG8_LDB(B0, 0, 0); PG8_LDB(B1, 0, 1); PG8_SCHED; PG8_LDA(At, 0, 0); PG8_STAGE(PG8_SA(1, 1), a1 + hstepA, voffA);
            PG8_WAIT_V(8); PG8_WAIT_L(0); PG8_BAR; PG8_MMA(0, 0, At, B0); PG8_MMA(0, 1, At, B1); PG8_BAR; PG8_SCHED;
            PG8_LDA(At, 0, 1); PG8_STAGE(PG8_SB(0, 0), b2, voffB); PG8_STAGE(PG8_SB(0, 1), b2 + hstepB, voffB); PG8_STAGE(PG8_SA(0, 0), a2, voffA);
            PG8_WAIT_V(8); PG8_WAIT_L(0); PG8_BAR; PG8_MMA(1, 0, At, B0); PG8_MMA(1, 1, At, B1); PG8_BAR; PG8_SCHED;
            PG8_LDB(B0, 1, 0); PG8_LDB(B1, 1, 1); PG8_SCHED; PG8_LDA(At, 1, 0); PG8_STAGE(PG8_SA(0, 1), a2 + hstepA, voffA);
            PG8_WAIT_V(8); PG8_WAIT_L(0); PG8_BAR; PG8_MMA(0, 0, At, B0); PG8_MMA(0, 1, At, B1); PG8_BAR; PG8_SCHED;
            PG8_LDA(At, 1, 1); PG8_STAGE(PG8_SB(1, 0), b3, voffB); PG8_STAGE(PG8_SB(1, 1), b3 + hstepB, voffB); PG8_STAGE(PG8_SA(1, 0), a3, voffA);
            PG8_WAIT_V(8); PG8_WAIT_L(0); PG8_BAR; PG8_MMA(1, 0, At, B0); PG8_MMA(1, 1, At, B1); PG8_BAR; PG8_SCHED;
        }
        if constexpr (ALIGN_EPI) { if (wr == 0) PG8_BAR; }
        if constexpr (!Epi::AFTER_DRAIN) E(acc, cur, wr, wc, fr, fq);
        if (!has_next) break;
#pragma unroll
        for (int a = 0; a < 2; ++a)
#pragma unroll
            for (int b = 0; b < 2; ++b)
#pragma unroll
                for (int m = 0; m < 4; ++m)
#pragma unroll
                    for (int n = 0; n < 2; ++n) acc[a][b][m][n] = (f32x4){0.f, 0.f, 0.f, 0.f};
        cur = nxt; cA = nA; cB = nB; ++ui;
        if constexpr (ALIGN_EPI) { if (wr == 1) PG8_BAR; }
    }
    PG8_WAIT_V(0);
    if constexpr (!ALIGN_EPI) { if (wr == 0) PG8_BAR; }
    PG8_BAR;
    if constexpr (Epi::AFTER_DRAIN) E.fused(acc, cur, wr, wc, fr, fq, lds, wid, lane);
#undef PG8_SA
#undef PG8_SB
#undef PG8_STAGE
#undef PG8_LDA
#undef PG8_LDB
#undef PG8_MMA
#undef PG8_WAIT_V
#undef PG8_WAIT_L
#undef PG8_BAR
#undef PG8_SCHED
}
}

struct Ctx { LAS unsigned char* lds; int tid, lane, wid, G, bid; };

DI void conv_item(const float* W, int K, int Nsrc, bf16_t* WT, int mode, LAS float* scr, int item, int nblk, int lane) {
    const int kb = item / nblk, nb = item % nblk, k0 = 64 * kb, n0 = 32 * nb;
    const int n = n0 + (lane & 31);
    int src = n; bool ok = n < Nsrc;
    if (mode == 1) { const int pn = n >> 8, bj = (n >> 7) & 1, jj = n & 127; src = bj * DFF + pn * 128 + jj; ok = true; }
    float wv[32];
    const int srcc = ok ? src : 0;
#pragma unroll
    for (int i = 0; i < 32; ++i) { const int kk = 2 * i + (lane >> 5); wv[i] = W[(size_t)(k0 + kk) * Nsrc + srcc]; }
#pragma unroll
    for (int i = 0; i < 32; ++i) { const int kk = 2 * i + (lane >> 5); scr[kk * 33 + (lane & 31)] = ok ? wv[i] : 0.f; }
    asm volatile("s_waitcnt lgkmcnt(0)" ::: "memory");
    const int c = lane & 7;
#pragma unroll
    for (int j = 0; j < 4; ++j) { const int nn = (lane >> 3) + 8 * j; const LAS float* s = scr + (8 * c) * 33 + nn;
        u32x4 o; o.x = pk2(s[0 * 33], s[1 * 33]); o.y = pk2(s[2 * 33], s[3 * 33]); o.z = pk2(s[4 * 33], s[5 * 33]); o.w = pk2(s[6 * 33], s[7 * 33]);
        *(u32x4*)(WT + (size_t)(n0 + nn) * K + k0 + 8 * c) = o; }
    asm volatile("s_waitcnt lgkmcnt(0)" ::: "memory");
}

struct LayerW { const float *a1, *a2, *mi, *uq, *ukv, *wo, *b1, *b2, *gt, *pp; };
template <int SET> DI void conv_phase(const Ctx& c, const LayerW& L, bf16_t* W, const int gw, const int NGW) {
    LAS float* scr = (LAS float*)(c.lds + c.wid * 8448);
    constexpr int I_A1 = 16 * 176, I_A2 = 44 * 32, I_MI = 16 * 104, I_UQ = 4 * 12, I_UKV = 2 * 16, I_O = 16 * 32, I_P = 4 * 32;
    constexpr int NITEMS = SET == 0 ? I_A1 + I_A2 : SET == 1 ? I_MI + I_UQ + I_UKV + I_O : I_A1 + I_A2 + I_O + I_P;
    for (int it = gw; it < NITEMS; it += NGW) {
        int r = it;
        if constexpr (SET == 0) {
            if (r < I_A1) { conv_item(L.a1, 1024, 5632, W + OW_A1, 1, scr, r, 176, c.lane); continue; } r -= I_A1;
            conv_item(L.a2, 2816, 1024, W + OW_A2, 0, scr, r, 32, c.lane);
        } else if constexpr (SET == 1) {
            if (r < I_MI) { conv_item(L.mi, 1024, NIN, W + OW_MI, 0, scr, r, 104, c.lane); continue; } r -= I_MI;
            if (r < I_UQ) { conv_item(L.uq, 256, 384, W + OW_UQ, 0, scr, r, 12, c.lane); continue; } r -= I_UQ;
            if (r < I_UKV) { conv_item(L.ukv, 128, 512, W + OW_UKV, 0, scr, r, 16, c.lane); continue; } r -= I_UKV;
            conv_item(L.wo, 1024, 1024, W + OW_O, 0, scr, r, 32, c.lane);
        } else {
            if (r < I_A1) { conv_item(L.b1, 1024, 5632, W + OW_B1, 1, scr, r, 176, c.lane); continue; } r -= I_A1;
            if (r < I_A2) { conv_item(L.b2, 2816, 1024, W + OW_B2, 0, scr, r, 32, c.lane); continue; } r -= I_A2;
            if (r < I_O) { conv_item(L.gt, 1024, 1024, W + OW_GT, 0, scr, r, 32, c.lane); continue; } r -= I_O;
            conv_item(L.pp, 256, 1024, W + OW_P, 0, scr, r, 32, c.lane);
        }
    }
}

DI void ln_phase(const Ctx& c, float* H, bf16_t* HB, const float* g, const float* b) {
    const int gw = c.bid * 8 + c.wid, NGW = c.G * 8;
    for (int m = 2 * gw; m < T_; m += 2 * NGW) {
        f32x4* xr0 = (f32x4*)(H + (size_t)m * DM) + c.lane; f32x4* xr1 = xr0 + DM / 4;
        f32x4 v0[4], v1[4]; float s0 = 0.f, q0 = 0.f, s1 = 0.f, q1 = 0.f;
#pragma unroll
        for (int j = 0; j < 4; ++j) { v0[j] = xr0[64 * j]; v1[j] = xr1[64 * j]; }
#pragma unroll
        for (int j = 0; j < 4; ++j) { s0 += (v0[j][0] + v0[j][1]) + (v0[j][2] + v0[j][3]); q0 += (v0[j][0] * v0[j][0] + v0[j][1] * v0[j][1]) + (v0[j][2] * v0[j][2] + v0[j][3] * v0[j][3]);
            s1 += (v1[j][0] + v1[j][1]) + (v1[j][2] + v1[j][3]); q1 += (v1[j][0] * v1[j][0] + v1[j][1] * v1[j][1]) + (v1[j][2] * v1[j][2] + v1[j][3] * v1[j][3]); }
#pragma unroll
        for (int o = 1; o < 64; o <<= 1) { s0 += __shfl_xor(s0, o); q0 += __shfl_xor(q0, o); s1 += __shfl_xor(s1, o); q1 += __shfl_xor(q1, o); }
        const float mean0 = s0 * (1.f / DM), mean1 = s1 * (1.f / DM);
        const float rstd0 = __builtin_amdgcn_rsqf(fmaxf(q0 * (1.f / DM) - mean0 * mean0, 0.f) + LN_EPS), rstd1 = __builtin_amdgcn_rsqf(fmaxf(q1 * (1.f / DM) - mean1 * mean1, 0.f) + LN_EPS);
        u32x2* o80 = (u32x2*)(HB + (size_t)m * DM) + c.lane; u32x2* o81 = o80 + DM / 4;
#pragma unroll
        for (int j = 0; j < 4; ++j) { const f32x4 gg = ((const f32x4*)g)[c.lane + 64 * j], bb = ((const f32x4*)b)[c.lane + 64 * j];
            const f32x4 a0 = (v0[j] - mean0) * rstd0 * gg + bb, a1 = (v1[j] - mean1) * rstd1 * gg + bb; xr0[64 * j] = a0; xr1[64 * j] = a1;
            u32x2 w0; w0.x = pk2(a0[0], a0[1]); w0.y = pk2(a0[2], a0[3]); o80[64 * j] = w0; u32x2 w1; w1.x = pk2(a1[0], a1[1]); w1.y = pk2(a1[2], a1[3]); o81[64 * j] = w1; }
    }
}
DI void cvt_phase(const Ctx& c, const float* src, bf16_t* dst, float* copy, size_t n) {
    const size_t n4 = n / 4, stride = (size_t)c.G * 512;
    for (size_t i = (size_t)c.bid * 512 + c.tid; i < n4; i += stride) { const f32x4 v = ((const f32x4*)src)[i]; u32x2 w; w.x = pk2(v[0], v[1]); w.y = pk2(v[2], v[3]); ((u32x2*)dst)[i] = w; if (copy) ((f32x4*)copy)[i] = v; }
}
DI void rope_phase(const Ctx& c, const int* pos, f32x2* RT) {
    for (int i = c.bid * 512 + c.tid; i < T_ * 16; i += c.G * 512) {
        const int t = i >> 4, f = i & 15;
        const float e = (float)(2 * f) / 32.0f;
        const float pw = (float)exp2((double)e * 13.287712379549449);
        const float inv = 1.0f / pw;
        const float ang = (float)pos[t] * inv;
        const double rev = (double)ang * 0.15915494309189535; const float fr = (float)(rev - floor(rev));
        RT[i] = (f32x2){__builtin_amdgcn_cosf(fr), __builtin_amdgcn_sinf(fr)};
    }
}

DI void gdn_prefetch(const Ctx& c, int item, const bf16_t* proj, u32x4 (&x)[12], bf16_t& ga, bf16_t& gb) {
    const int tid = c.tid; const int b = item >> 9, h = (item >> 6) & 7, n = item & 63; const int t = tid >> 3, cg8 = tid & 7;
#pragma unroll
    for (int which = 0; which < 3; ++which)
#pragma unroll
        for (int j = 0; j < 4; ++j) { const int sp = n * 64 + t - 3 + j; const int spc = sp >= 0 ? sp : 0;
            x[which * 4 + j] = *(const u32x4*)(proj + (size_t)(b * SEQ + spc) * NINP + which * 512 + h * 64 + cg8 * 8); }
    const size_t ro = (size_t)(b * SEQ + n * 64 + (tid & 63)) * NINP; ga = proj[ro + C_GA + h]; gb = proj[ro + C_GB + h];
}
DI void gdn_prep_item(const Ctx& c, int item, int next_item, u32x4 (&xin)[12], bf16_t& gain, bf16_t& gbin, const bf16_t* proj, const float* conv_w, const float* a_log, const float* dt_bias, unsigned char* gbase, float* GL, const int stop = 0) {
    const int tid = c.tid, lane = c.lane, wid = c.wid;
    const int b = item >> 9, h = (item >> 6) & 7, n = item & 63;
    const int tok0 = b * SEQ + n * 64;
    LAS float* qc = (LAS float*)c.lds; LAS float* kc = qc + 64 * 68; LAS float* vc = kc + 64 * 68; LAS float* Lm = vc + 64 * 68; LAS float* rhs = Lm + 64 * 68; LAS float* gcs = rhs + 64 * 132; LAS float* bet = gcs + 64;
    LAS bf16_t* KH = (LAS bf16_t*)(bet + 64); LAS bf16_t* KL = KH + 64 * 72; LAS bf16_t* QH = KL + 64 * 72; LAS bf16_t* QL = QH + 64 * 72;
    unsigned char* gout = gbase + (size_t)item * GSLOT;
#pragma unroll
    for (int which = 0; which < 3; ++which) {
        const int t = tid >> 3, cg8 = tid & 7; const int col = which * 512 + h * 64 + cg8 * 8;
        float acc[8];
#pragma unroll
        for (int e = 0; e < 8; ++e) acc[e] = 0.f;
#pragma unroll
        for (int j = 0; j < 4; ++j) { const int sp = n * 64 + t - 3 + j; const float ok = sp >= 0 ? 1.f : 0.f;
            const u32x4 xv = xin[which * 4 + j];
            const f32x4 w0 = *(const f32x4*)(conv_w + j * 1536 + col) * ok, w1 = *(const f32x4*)(conv_w + j * 1536 + col + 4) * ok;
            acc[0] += w0[0] * bflo(xv.x); acc[1] += w0[1] * bfhi(xv.x); acc[2] += w0[2] * bflo(xv.y); acc[3] += w0[3] * bfhi(xv.y);
            acc[4] += w1[0] * bflo(xv.z); acc[5] += w1[1] * bfhi(xv.z); acc[6] += w1[2] * bflo(xv.w); acc[7] += w1[3] * bfhi(xv.w); }
#pragma unroll
        for (int e = 0; e < 8; ++e) acc[e] = silu_f(acc[e]);
        if (which == 2) { LAS float* dst = vc + t * 68 + cg8 * 8; *(LAS f32x4*)dst = (f32x4){acc[0], acc[1], acc[2], acc[3]}; *(LAS f32x4*)(dst + 4) = (f32x4){acc[4], acc[5], acc[6], acc[7]}; }
        else {
            float ss = (acc[0] * acc[0] + acc[1] * acc[1]) + (acc[2] * acc[2] + acc[3] * acc[3]) + (acc[4] * acc[4] + acc[5] * acc[5]) + (acc[6] * acc[6] + acc[7] * acc[7]);
            ss += __shfl_xor(ss, 1); ss += __shfl_xor(ss, 2); ss += __shfl_xor(ss, 4);
            const float sc = (which ? 1.0f : 0.125f) * __builtin_amdgcn_rsqf(ss + 1e-6f);
            const f32x4 y0 = (f32x4){acc[0], acc[1], acc[2], acc[3]} * sc, y1 = (f32x4){acc[4], acc[5], acc[6], acc[7]} * sc;
            LAS float* dst = (which ? kc : qc) + t * 68 + cg8 * 8; *(LAS f32x4*)dst = y0; *(LAS f32x4*)(dst + 4) = y1;
            u32x4 hh; hh.x = pk2(y0[0], y0[1]); hh.y = pk2(y0[2], y0[3]); hh.z = pk2(y1[0], y1[1]); hh.w = pk2(y1[2], y1[3]);
            u32x4 lo; lo.x = pk2(y0[0] - bflo(hh.x), y0[1] - bfhi(hh.x)); lo.y = pk2(y0[2] - bflo(hh.y), y0[3] - bfhi(hh.y)); lo.z = pk2(y1[0] - bflo(hh.z), y1[1] - bfhi(hh.z)); lo.w = pk2(y1[2] - bflo(hh.w), y1[3] - bfhi(hh.w));
            *(LAS u32x4*)((which ? KH : QH) + t * 72 + cg8 * 8) = hh; *(LAS u32x4*)((which ? KL : QL) + t * 72 + cg8 * 8) = lo; }
    }
    { const float ga = bf2f(gain), gb = bf2f(gbin);
        const float x = ga + dt_bias[h]; const float sp = fmaxf(x, 0.f) + log1pf(expf(-fabsf(x)));
        float gv = -expf(a_log[h]) * sp; const float bv = 1.f / (1.f + expf(-gb));
        if (wid == 0) {
#pragma unroll
            for (int o = 1; o < 64; o <<= 1) { const float tt = __shfl_up(gv, o); if (lane >= o) gv += tt; }
            gcs[lane] = gv; bet[lane] = bv; } }
    LBAR();
    if (stop == 3) return;
    LAS float* DIV = (LAS float*)(c.lds + 140800);
    const float glog = gcs[63];
    gdn_prefetch(c, next_item, proj, xin, gain, gbin);
    { const int l31 = lane & 31, hi = lane >> 5; const int isqk = wid >> 2, jt = (wid >> 1) & 1, it = wid & 1;
        if (jt <= it) {
            const LAS bf16_t* BH = isqk ? QH : KH; const LAS bf16_t* BL = isqk ? QL : KL;
            bf16x8 aH[4], aLo[4], bH[4], bLo[4];
#pragma unroll
            for (int ks = 0; ks < 4; ++ks) { const int ao = (32 * jt + l31) * 72 + 16 * ks + 8 * hi, bo = (32 * it + l31) * 72 + 16 * ks + 8 * hi;
                aH[ks] = *(const LAS bf16x8*)(KH + ao); aLo[ks] = *(const LAS bf16x8*)(KL + ao); bH[ks] = *(const LAS bf16x8*)(BH + bo); bLo[ks] = *(const LAS bf16x8*)(BL + bo); }
            __builtin_amdgcn_sched_barrier(0);
            f32x16 acc;
#pragma unroll
            for (int r = 0; r < 16; ++r) acc[r] = 0.f;
#pragma unroll
            for (int ks = 0; ks < 4; ++ks) { acc = MFMA32(aH[ks], bH[ks], acc); acc = MFMA32(aH[ks], bLo[ks], acc); acc = MFMA32(aLo[ks], bH[ks], acc); }
            const int i = 32 * it + l31; const float gi = gcs[i], bi = bet[i];
#pragma unroll
            for (int r = 0; r < 16; ++r) { const int j = 32 * jt + crow(r, hi); const float d = fexp2((gi - gcs[j]) * 1.4426950408889634f);
                if (isqk) acc[r] = (j <= i) ? acc[r] * d : 0.f; else Lm[j * 68 + i] = (j < i) ? bi * acc[r] * d : 0.f; }
            if (isqk) {
#pragma unroll
                for (int sx = 0; sx < 2; ++sx) { const bf16x8 pk = pack8(acc, sx); *(u32x4*)(gout + 2 * 8192 + ((it * 4 + 2 * jt + sx) * 64 + lane) * 16) = __builtin_bit_cast(u32x4, pk); } }
            else if (jt == it) {
                const int bb = 2 * jt + ((lane >> 4) & 1), col = lane & 15;
                float y[16];
#pragma unroll
                for (int ii = 0; ii < 16; ++ii) y[ii] = (ii == col) ? 1.f : 0.f;
#pragma unroll
                for (int j = 0; j < 15; ++j) { const float yj = y[j];
#pragma unroll
                    for (int q4 = (j + 1) / 4; q4 < 4; ++q4) { const f32x4 l4 = *(const LAS f32x4*)(Lm + (16 * bb + j) * 68 + 16 * bb + 4 * q4);
#pragma unroll
                        for (int e = 0; e < 4; ++e) if (4 * q4 + e > j) y[4 * q4 + e] -= l4[e] * yj; } }
#pragma unroll
                for (int ii = 0; ii < 16; ++ii) DIV[bb * 320 + ii * 20 + col] = y[ii];
            }
        } else if (isqk) {
#pragma unroll
            for (int sx = 0; sx < 2; ++sx) *(u32x4*)(gout + 2 * 8192 + ((it * 4 + 2 * jt + sx) * 64 + lane) * 16) = (u32x4){0u, 0u, 0u, 0u};
        }
    }
#pragma unroll 2
    for (int e = tid; e < 8192; e += 512) { const int i = e >> 7, cc = e & 127; const float bi = bet[i];
        rhs[i * 132 + cc] = cc < 64 ? vc[i * 68 + cc] * bi : kc[i * 68 + cc - 64] * bi * fexp2(gcs[i] * 1.4426950408889634f); }
#pragma unroll 1
    for (int q = 0; q < 2; ++q) { const int ch = tid + 512 * q; const int mat = ch < 512 ? 1 : 3, idx = ch & 511;
        const int mt = idx >> 8, ks = (idx >> 6) & 3, ln = idx & 63, i = 32 * mt + (ln & 31), hh = ln >> 5, k0 = 16 * ks + 4 * hh;
        float v[8];
        if (mat == 1) { const float e = fexp2(gcs[i] * 1.4426950408889634f); const f32x4 a = *(const LAS f32x4*)(qc + i * 68 + k0), bq = *(const LAS f32x4*)(qc + i * 68 + k0 + 8);
#pragma unroll
            for (int x = 0; x < 4; ++x) { v[x] = a[x] * e; v[4 + x] = bq[x] * e; } }
        else {
#pragma unroll
            for (int x = 0; x < 8; ++x) { const int cr = k0 + (x & 3) + 8 * (x >> 2); v[x] = kc[cr * 68 + i] * fexp2((glog - gcs[cr]) * 1.4426950408889634f); } }
        u32x4 w; w.x = pk2(v[0], v[1]); w.y = pk2(v[2], v[3]); w.z = pk2(v[4], v[5]); w.w = pk2(v[6], v[7]);
        *(u32x4*)(gout + mat * 8192 + idx * 16) = w; }
    LBAR();
    if (stop == 4) return;
    {
        const int g = lane >> 4, nn = lane & 15, cb = 16 * wid + nn;
#pragma unroll
        for (int blk = 0; blk < 4; ++blk) {
            f32x4 acc;
#pragma unroll
            for (int r = 0; r < 4; ++r) acc[r] = rhs[(16 * blk + 4 * g + r) * 132 + cb];
#pragma unroll
            for (int k4 = 0; k4 < 4 * blk; ++k4) { const float av = -Lm[(4 * k4 + g) * 68 + 16 * blk + nn], bv = rhs[(4 * k4 + g) * 132 + cb];
                acc = __builtin_amdgcn_mfma_f32_16x16x4f32(av, bv, acc, 0, 0, 0); }
#pragma unroll
            for (int r = 0; r < 4; ++r) rhs[(16 * blk + 4 * g + r) * 132 + cb] = acc[r];
            f32x4 xs = (f32x4){0.f, 0.f, 0.f, 0.f};
#pragma unroll
            for (int k4 = 0; k4 < 4; ++k4) { const float av = DIV[blk * 320 + nn * 20 + 4 * k4 + g], bv = rhs[(16 * blk + 4 * k4 + g) * 132 + cb];
                xs = __builtin_amdgcn_mfma_f32_16x16x4f32(av, bv, xs, 0, 0, 0); }
#pragma unroll
            for (int r = 0; r < 4; ++r) rhs[(16 * blk + 4 * g + r) * 132 + cb] = xs[r];
        }
    }
    LBAR();
    if (stop == 5) return;
    {
        const int idx = tid; const int mt = idx >> 8, ks = (idx >> 6) & 3, ln = idx & 63, i = 32 * mt + (ln & 31), hh = ln >> 5, k0 = 16 * ks + 4 * hh;
        const f32x4 a = *(const LAS f32x4*)(rhs + i * 132 + 64 + k0), bq = *(const LAS f32x4*)(rhs + i * 132 + 64 + k0 + 8);
        u32x4 w; w.x = pk2(-a[0], -a[1]); w.y = pk2(-a[2], -a[3]); w.z = pk2(-bq[0], -bq[1]); w.w = pk2(-bq[2], -bq[3]);
        *(u32x4*)(gout + idx * 16) = w;
        const int tile = idx >> 7, ln2 = (idx >> 1) & 63, half = idx & 1, ct = tile >> 1, vt = tile & 1, vcol = 32 * vt + (ln2 & 31), h2 = ln2 >> 5;
        float v[8];
#pragma unroll
        for (int e = 0; e < 8; ++e) { const int r = 8 * half + e; v[e] = rhs[(32 * ct + crow(r, h2)) * 132 + vcol]; }
        u32x4 wu; wu.x = pk2(v[0], v[1]); wu.y = pk2(v[2], v[3]); wu.z = pk2(v[4], v[5]); wu.w = pk2(v[6], v[7]);
        *(u32x4*)(gout + 4 * 8192 + idx * 16) = wu;
        if (tid == 0) GL[item] = expf(glog);
    }
}

DI int pos16(int t) { const int x = t & 15; return (t & ~15) | (8 * ((x >> 2) & 1) + 4 * (x >> 3) + (x & 3)); }
DI void mla_prep_item(const Ctx& c, int item, const bf16_t* proj, const float* qnw, const float* kvnw, const bf16_t* Wuq, const bf16_t* Wukv, const f32x2* RT,
                      bf16_t* MQ, bf16_t* MK, bf16_t* MVT, bf16_t* SVT) {
    const int tid = c.tid, lane = c.lane, wid = c.wid;
    const int tok0 = item * 64, b = item >> 6, s0 = (item & 63) * 64;
    LAS bf16_t* A1 = (LAS bf16_t*)c.lds;
    LAS bf16_t* A2 = (LAS bf16_t*)(c.lds + 33792);
    LAS bf16_t* OUT = (LAS bf16_t*)(c.lds + 51200);
    LAS bf16_t* VT = (LAS bf16_t*)(c.lds + 101376);
    LBAR();
    { const int row = 8 * wid + (lane >> 3), ch = lane & 7; const size_t ro = (size_t)(tok0 + row) * NINP;
        u32x4 xq[4], xk[2];
#pragma unroll
        for (int q = 0; q < 4; ++q) xq[q] = *(const u32x4*)(proj + ro + C_MQ + ch * 32 + q * 8);
#pragma unroll
        for (int q = 0; q < 2; ++q) xk[q] = *(const u32x4*)(proj + ro + C_CKV + ch * 16 + q * 8);
        const unsigned r1 = *(const unsigned*)(proj + ro + C_KR + 2 * ch), r2 = *(const unsigned*)(proj + ro + C_KR + 16 + 2 * ch);
        const f32x4 cs = *(const f32x4*)(RT + (size_t)(tok0 + row) * 16 + 2 * ch);
        float ss = 0.f, sk = 0.f;
#pragma unroll
        for (int q = 0; q < 4; ++q) { ss += bflo(xq[q].x) * bflo(xq[q].x) + bfhi(xq[q].x) * bfhi(xq[q].x) + bflo(xq[q].y) * bflo(xq[q].y) + bfhi(xq[q].y) * bfhi(xq[q].y)
                                          + bflo(xq[q].z) * bflo(xq[q].z) + bfhi(xq[q].z) * bfhi(xq[q].z) + bflo(xq[q].w) * bflo(xq[q].w) + bfhi(xq[q].w) * bfhi(xq[q].w); }
#pragma unroll
        for (int q = 0; q < 2; ++q) { sk += bflo(xk[q].x) * bflo(xk[q].x) + bfhi(xk[q].x) * bfhi(xk[q].x) + bflo(xk[q].y) * bflo(xk[q].y) + bfhi(xk[q].y) * bfhi(xk[q].y)
                                          + bflo(xk[q].z) * bflo(xk[q].z) + bfhi(xk[q].z) * bfhi(xk[q].z) + bflo(xk[q].w) * bflo(xk[q].w) + bfhi(xk[q].w) * bfhi(xk[q].w); }
        ss += __shfl_xor(ss, 1); sk += __shfl_xor(sk, 1); ss += __shfl_xor(ss, 2); sk += __shfl_xor(sk, 2); ss += __shfl_xor(ss, 4); sk += __shfl_xor(sk, 4);
        const float rq = __builtin_amdgcn_rsqf(ss * (1.f / 256.f) + 1e-6f), rk = __builtin_amdgcn_rsqf(sk * (1.f / 128.f) + 1e-6f);
        __builtin_amdgcn_sched_barrier(0);
#pragma unroll
        for (int q = 0; q < 4; ++q) { const f32x4 n0 = *(const f32x4*)(qnw + ch * 32 + q * 8), n1 = *(const f32x4*)(qnw + ch * 32 + q * 8 + 4); u32x4 o;
            o.x = pk2(bflo(xq[q].x) * rq * n0[0], bfhi(xq[q].x) * rq * n0[1]); o.y = pk2(bflo(xq[q].y) * rq * n0[2], bfhi(xq[q].y) * rq * n0[3]);
            o.z = pk2(bflo(xq[q].z) * rq * n1[0], bfhi(xq[q].z) * rq * n1[1]); o.w = pk2(bflo(xq[q].w) * rq * n1[2], bfhi(xq[q].w) * rq * n1[3]);
            *(LAS u32x4*)(A1 + row * 264 + ch * 32 + q * 8) = o; __builtin_amdgcn_sched_barrier(0); }
#pragma unroll
        for (int q = 0; q < 2; ++q) { const f32x4 n0 = *(const f32x4*)(kvnw + ch * 16 + q * 8), n1 = *(const f32x4*)(kvnw + ch * 16 + q * 8 + 4); u32x4 o;
            o.x = pk2(bflo(xk[q].x) * rk * n0[0], bfhi(xk[q].x) * rk * n0[1]); o.y = pk2(bflo(xk[q].y) * rk * n0[2], bfhi(xk[q].y) * rk * n0[3]);
            o.z = pk2(bflo(xk[q].z) * rk * n1[0], bfhi(xk[q].z) * rk * n1[1]); o.w = pk2(bflo(xk[q].w) * rk * n1[2], bfhi(xk[q].w) * rk * n1[3]);
            *(LAS u32x4*)(A2 + row * 136 + ch * 16 + q * 8) = o; __builtin_amdgcn_sched_barrier(0); }
        { const float x1a = bflo(r1), x1b = bfhi(r1), x2a = bflo(r2), x2b = bfhi(r2);
            const unsigned y1 = pk2(x1a * cs[0] - x2a * cs[1], x1b * cs[2] - x2b * cs[3]), y2 = pk2(x2a * cs[0] + x1a * cs[1], x2b * cs[2] + x1b * cs[3]);
#pragma unroll
            for (int hh = 0; hh < 4; ++hh) { *(unsigned*)(MK + (size_t)(tok0 + row) * 384 + hh * 96 + 64 + 2 * ch) = y1; *(unsigned*)(MK + (size_t)(tok0 + row) * 384 + hh * 96 + 80 + 2 * ch) = y2; } }
    }
#pragma unroll
    for (int q = 0; q < 4; ++q) { const int ch = tid + 512 * q, t = ch & 63, c8 = ch >> 6; const u32x4 w = *(const u32x4*)(proj + (size_t)(tok0 + t) * NINP + C_SV + c8 * 8); const int p = pos16(t);
        VT[(c8 * 8 + 0) * 72 + p] = (bf16_t)(w.x & 0xffff); VT[(c8 * 8 + 1) * 72 + p] = (bf16_t)(w.x >> 16); VT[(c8 * 8 + 2) * 72 + p] = (bf16_t)(w.y & 0xffff); VT[(c8 * 8 + 3) * 72 + p] = (bf16_t)(w.y >> 16);
        VT[(c8 * 8 + 4) * 72 + p] = (bf16_t)(w.z & 0xffff); VT[(c8 * 8 + 5) * 72 + p] = (bf16_t)(w.z >> 16); VT[(c8 * 8 + 6) * 72 + p] = (bf16_t)(w.w & 0xffff); VT[(c8 * 8 + 7) * 72 + p] = (bf16_t)(w.w >> 16); }
    LBAR();
#pragma unroll
    for (int q = 0; q < 4; ++q) { const int ch = tid + 512 * q, row = ch >> 3, cc = ch & 7; const u32x4 w = *(const LAS u32x4*)(VT + row * 72 + cc * 8);
        *(u32x4*)(SVT + ((size_t)(b * 4 + (row >> 6)) * 64 + (row & 63)) * SEQ + s0 + cc * 8) = w; }
    {
        f32x4 acc[4][3];
#pragma unroll
        for (int m = 0; m < 4; ++m)
#pragma unroll
            for (int nf = 0; nf < 3; ++nf) acc[m][nf] = (f32x4){0.f, 0.f, 0.f, 0.f};
#pragma unroll 2
        for (int kk = 0; kk < 8; ++kk) { bf16x8 a[4], bb[3];
#pragma unroll
            for (int m = 0; m < 4; ++m) a[m] = *(const LAS bf16x8*)(A1 + (16 * m + (lane & 15)) * 264 + kk * 32 + (lane >> 4) * 8);
#pragma unroll
            for (int nf = 0; nf < 3; ++nf) bb[nf] = *(const bf16x8*)(Wuq + (size_t)(16 * (3 * wid + nf) + (lane & 15)) * 256 + kk * 32 + (lane >> 4) * 8);
#pragma unroll
            for (int m = 0; m < 4; ++m)
#pragma unroll
                for (int nf = 0; nf < 3; ++nf) acc[m][nf] = MFMA16(a[m], bb[nf], acc[m][nf]); }
        const float SC = 0.10206207261596575f * 1.4426950408889634f;
#pragma unroll
        for (int m = 0; m < 4; ++m)
#pragma unroll
            for (int r = 0; r < 4; ++r) { const int t = 16 * m + 4 * (lane >> 4) + r;
                float v0 = acc[m][0][r], v1 = acc[m][1][r], v2 = acc[m][2][r];
                { const f32x2 cs = RT[(tok0 + t) * 16 + (lane & 15)]; const float y1 = v1 * cs[0] - v2 * cs[1], y2 = v2 * cs[0] + v1 * cs[1]; v1 = (wid & 1) ? y1 : v1; v2 = (wid & 1) ? y2 : v2; }
                LAS bf16_t* o = OUT + t * 392 + 48 * wid + (lane & 15);
                o[0] = f2bf(v0 * SC); o[16] = f2bf(v1 * SC); o[32] = f2bf(v2 * SC); }
    }
    LBAR();
#pragma unroll
    for (int q = 0; q < 6; ++q) { const int ch = tid + 512 * q, row = ch / 48, cc = ch % 48; const u32x4 w = *(const LAS u32x4*)(OUT + row * 392 + cc * 8);
        *(u32x4*)(MQ + (size_t)(tok0 + row) * 384 + cc * 8) = w; }
    LBAR();
    {   f32x4 acc[4][4];
#pragma unroll
        for (int m = 0; m < 4; ++m)
#pragma unroll
            for (int nf = 0; nf < 4; ++nf) acc[m][nf] = (f32x4){0.f, 0.f, 0.f, 0.f};
#pragma unroll 2
        for (int kk = 0; kk < 4; ++kk) { bf16x8 a[4], bb[4];
#pragma unroll
            for (int m = 0; m < 4; ++m) a[m] = *(const LAS bf16x8*)(A2 + (16 * m + (lane & 15)) * 136 + kk * 32 + (lane >> 4) * 8);
#pragma unroll
            for (int nf = 0; nf < 4; ++nf) bb[nf] = *(const bf16x8*)(Wukv + (size_t)(64 * wid + 16 * nf + (lane & 15)) * 128 + kk * 32 + (lane >> 4) * 8);
#pragma unroll
            for (int m = 0; m < 4; ++m)
#pragma unroll
                for (int nf = 0; nf < 4; ++nf) acc[m][nf] = MFMA16(a[m], bb[nf], acc[m][nf]); }
        const int hh = wid >> 1;
#pragma unroll
        for (int m = 0; m < 4; ++m)
#pragma unroll
            for (int r = 0; r < 4; ++r) { const int t = 16 * m + 4 * (lane >> 4) + r;
#pragma unroll
                for (int nf = 0; nf < 4; ++nf) { const bf16_t v = f2bf(acc[m][nf][r]);
                    if (wid & 1) VT[(hh * 64 + 16 * nf + (lane & 15)) * 72 + pos16(t)] = v; else OUT[t * 392 + hh * 96 + 16 * nf + (lane & 15)] = v; } }
    }
    LBAR();
#pragma unroll
    for (int q = 0; q < 4; ++q) { const int ch = tid + 512 * q, row = ch >> 5, hh = (ch >> 3) & 3, cc = ch & 7; const u32x4 w = *(const LAS u32x4*)(OUT + row * 392 + hh * 96 + cc * 8);
        *(u32x4*)(MK + (size_t)(tok0 + row) * 384 + hh * 96 + cc * 8) = w; }
#pragma unroll
    for (int q = 0; q < 4; ++q) { const int ch = tid + 512 * q, row = ch >> 3, cc = ch & 7; const u32x4 w = *(const LAS u32x4*)(VT + row * 72 + cc * 8);
        *(u32x4*)(MVT + ((size_t)(b * 4 + (row >> 6)) * 64 + (row & 63)) * SEQ + s0 + cc * 8) = w; }
}


DI void gdn_step(const Ctx& c, const int n, const int vt, const LAS unsigned char* lds0, f32x16& S0, f32x16& S1, const float gl, bf16_t* proj, const int b, const int h) {
    const int lane = c.lane, hi = lane >> 5;
    const LAS unsigned char* sl = lds0 + (n % 3) * GSLOT;
    bf16x8 sb[4]; sb[0] = pack8(S0, 0); sb[1] = pack8(S0, 1); sb[2] = pack8(S1, 0); sb[3] = pack8(S1, 1);
    f32x16 vn[2], o[2];
#pragma unroll
    for (int ct = 0; ct < 2; ++ct) { const u32x4 u0 = *(const LAS u32x4*)(sl + 4 * 8192 + ((ct * 2 + vt) * 64 + lane) * 32), u1 = *(const LAS u32x4*)(sl + 4 * 8192 + ((ct * 2 + vt) * 64 + lane) * 32 + 16);
        vn[ct][0] = bflo(u0.x); vn[ct][1] = bfhi(u0.x); vn[ct][2] = bflo(u0.y); vn[ct][3] = bfhi(u0.y); vn[ct][4] = bflo(u0.z); vn[ct][5] = bfhi(u0.z); vn[ct][6] = bflo(u0.w); vn[ct][7] = bfhi(u0.w);
        vn[ct][8] = bflo(u1.x); vn[ct][9] = bfhi(u1.x); vn[ct][10] = bflo(u1.y); vn[ct][11] = bfhi(u1.y); vn[ct][12] = bflo(u1.z); vn[ct][13] = bfhi(u1.z); vn[ct][14] = bflo(u1.w); vn[ct][15] = bfhi(u1.w);
#pragma unroll
        for (int r = 0; r < 16; ++r) o[ct][r] = 0.f; }
#define GFRAG(mat, mt, ks) (*(const LAS bf16x8*)(sl + (mat) * 8192 + (((mt) * 4 + (ks)) * 64 + lane) * 16))
#define GLOAD4(dst, mat, mt) do { _Pragma("unroll") for (int ks_ = 0; ks_ < 4; ++ks_) dst[ks_] = GFRAG(mat, mt, ks_); } while (0)
#define SCHEDB() __builtin_amdgcn_sched_barrier(0)
#define MMA4(acc, fr, bop) do { _Pragma("unroll") for (int ks_ = 0; ks_ < 4; ++ks_) acc = MFMA32(fr[ks_], bop[ks_], acc); } while (0)
#define MMA8(acc0, acc1, f0, f1, bop) do { _Pragma("unroll") for (int ks_ = 0; ks_ < 4; ++ks_) { acc0 = MFMA32(f0[ks_], bop[ks_], acc0); acc1 = MFMA32(f1[ks_], bop[ks_], acc1); } } while (0)
    bf16x8 fa[4], fb[4], fc[4], fd[4];
    GLOAD4(fa, 0, 0); GLOAD4(fb, 0, 1); GLOAD4(fc, 1, 0); GLOAD4(fd, 1, 1); SCHEDB();
    MMA8(vn[0], vn[1], fa, fb, sb); SCHEDB();
    GLOAD4(fa, 3, 0); GLOAD4(fb, 3, 1); SCHEDB();
    MMA8(o[0], o[1], fc, fd, sb); SCHEDB();
    GLOAD4(fc, 2, 0); GLOAD4(fd, 2, 1); SCHEDB();
    bf16x8 vb[4]; vb[0] = pack8(vn[0], 0); vb[1] = pack8(vn[0], 1); vb[2] = pack8(vn[1], 0); vb[3] = pack8(vn[1], 1);
#pragma unroll
    for (int r = 0; r < 16; ++r) { S0[r] *= gl; S1[r] *= gl; }
    SCHEDB();
    MMA8(S0, S1, fa, fb, vb);
    MMA8(o[0], o[1], fc, fd, vb);
#undef MMA8
#undef GLOAD4
#undef SCHEDB
#undef MMA4
#undef GFRAG
    bf16_t* op = proj + (size_t)(b * SEQ + n * 64) * NINP + h * 64 + 32 * vt + (lane & 31);
#pragma unroll
    for (int ct = 0; ct < 2; ++ct)
#pragma unroll
        for (int r = 0; r < 16; ++r) op[(size_t)(32 * ct + crow(r, hi)) * NINP] = f2bf(o[ct][r]);
}

DI void gdn_scan(const Ctx& c, int bh, const unsigned char* gbase, const float* GL, bf16_t* proj, const float* normw) {
    const int tid = c.tid, lane = c.lane, wid = c.wid, hi = lane >> 5;
    const int b = bh >> 3, h = bh & 7;
    const unsigned char* src = gbase + (size_t)bh * 64 * GSLOT;
    __syncthreads();
#pragma unroll
    for (int q = 0; q < 5; ++q) { *(LAS u32x4*)(c.lds + tid * 16 + q * 8192) = *(const u32x4*)(src + tid * 16 + q * 8192);
        *(LAS u32x4*)(c.lds + GSLOT + tid * 16 + q * 8192) = *(const u32x4*)(src + GSLOT + tid * 16 + q * 8192); }
    f32x16 S0, S1;
#pragma unroll
    for (int r = 0; r < 16; ++r) { S0[r] = 0.f; S1[r] = 0.f; }
    LAS float* glds = (LAS float*)(c.lds + 3 * GSLOT);
    if (tid < 64) glds[tid] = GL[bh * 64 + tid];
    const int lw = wid - 2; const int np = lw < 4 ? 7 : 6;
#define GDMA(chunk) do { if ((chunk) < 64) { const unsigned char* g_ = src + (size_t)(chunk) * GSLOT + (size_t)(lw * 64 + lane) * 16; LAS unsigned char* d_ = c.lds + ((chunk) % 3) * GSLOT + lw * 1024; \
        _Pragma("unroll") for (int p = 0; p < 7; ++p) if (p < np) __builtin_amdgcn_global_load_lds((const unsigned*)(g_ + p * 6144), (LAS unsigned*)(d_ + p * 6144), 16, 0, 0); } } while (0)
    if (wid >= 2) GDMA(2);
    const LAS unsigned char* sl_base = c.lds;
    for (int n = 0; n < 64; ++n) {
        if (wid >= 2) { if (n + 2 < 64 && n > 0) { if (np == 7) asm volatile("s_waitcnt vmcnt(7)" ::: "memory"); else asm volatile("s_waitcnt vmcnt(6)" ::: "memory"); } else asm volatile("s_waitcnt vmcnt(0)" ::: "memory"); }
        LBAR();
        if (wid >= 2) { if (n > 0) GDMA(n + 2); }
        else gdn_step(c, n, wid, sl_base, S0, S1, glds[n], proj, b, h);
    }
#undef GDMA
    __syncthreads();
    { const int cg8 = tid & 7; const f32x4 nw0 = *(const f32x4*)(normw + cg8 * 8), nw1 = *(const f32x4*)(normw + cg8 * 8 + 4);
#pragma unroll 1
        for (int it0 = 0; it0 < 64; it0 += 8) {
            u32x4 ovv[8], zvv[8];
#pragma unroll
            for (int k = 0; k < 8; ++k) { const int row = (it0 + k) * 64 + (tid >> 3); const bf16_t* rp = proj + (size_t)(b * SEQ + row) * NINP;
                ovv[k] = *(const u32x4*)(rp + h * 64 + cg8 * 8); zvv[k] = *(const u32x4*)(rp + C_GZ + h * 64 + cg8 * 8); }
            __builtin_amdgcn_sched_barrier(0);
#pragma unroll
            for (int k = 0; k < 8; ++k) { const int row = (it0 + k) * 64 + (tid >> 3); bf16_t* rp = proj + (size_t)(b * SEQ + row) * NINP; const u32x4 ov = ovv[k], zv = zvv[k];
                float o[8] = {bflo(ov.x), bfhi(ov.x), bflo(ov.y), bfhi(ov.y), bflo(ov.z), bfhi(ov.z), bflo(ov.w), bfhi(ov.w)};
                const float z[8] = {bflo(zv.x), bfhi(zv.x), bflo(zv.y), bfhi(zv.y), bflo(zv.z), bfhi(zv.z), bflo(zv.w), bfhi(zv.w)};
                float ss = 0.f;
#pragma unroll
                for (int e = 0; e < 8; ++e) ss += o[e] * o[e];
                ss += __shfl_xor(ss, 1); ss += __shfl_xor(ss, 2); ss += __shfl_xor(ss, 4);
                const float rs = __builtin_amdgcn_rsqf(ss * (1.f / 64.f) + 1e-6f);
#pragma unroll
                for (int e = 0; e < 8; ++e) o[e] = o[e] * rs * (e < 4 ? nw0[e & 3] : nw1[e & 3]) * silu_f(z[e]);
                u32x4 w; w.x = pk2(o[0], o[1]); w.y = pk2(o[2], o[3]); w.z = pk2(o[4], o[5]); w.w = pk2(o[6], o[7]);
                *(u32x4*)(rp + h * 64 + cg8 * 8) = w; }
        }
    }
}

template <int MODE>
DI void attn_unit(const Ctx& c, int bh, int qb, const bf16_t* Qp, int qpitch, const bf16_t* Kp, int kpitch, const bf16_t* VTp, bf16_t* Op, int opitch) {
    constexpr int DQK = MODE ? 96 : 64, NKS = DQK / 16, KSTR = (DQK + 8) * 2, CPR = DQK / 8, KBYTES = 64 * KSTR;
    const int tid = c.tid, lane = c.lane, wid = c.wid, l31 = lane & 31, hi = lane >> 5;
    const int b = bh >> 2, hh = bh & 3; const size_t rowbase = (size_t)b * SEQ;
    const int q0 = qb * 256, qw0 = q0 + 32 * wid, NT = 4 * qb + 4;
    LAS unsigned char* KB = c.lds; LAS unsigned char* VB = c.lds + 2 * KBYTES; LAS bf16_t* OST = (LAS bf16_t*)(c.lds + 2 * KBYTES + 2 * 9216 + wid * 4608);
    const bf16_t* Kh = Kp + rowbase * kpitch + hh * DQK; const bf16_t* Vh = VTp + (size_t)(b * 4 + hh) * 64 * SEQ;
    bf16x8 qf[NKS];
#pragma unroll
    for (int ks = 0; ks < NKS; ++ks) qf[ks] = *(const bf16x8*)(Qp + (rowbase + qw0 + l31) * qpitch + hh * DQK + 16 * ks + 8 * hi);
    f32x16 o[2];
#pragma unroll
    for (int r = 0; r < 16; ++r) { o[0][r] = 0.f; o[1][r] = 0.f; }
    float mrun = -1e30f, lrun = 0.f, R = 0.f;
    bf16x8 uf[2];
    if (MODE == 0) {
#pragma unroll
        for (int s = 0; s < 2; ++s)
#pragma unroll
            for (int j = 0; j < 8; ++j) { const int k = 16 * s + 8 * (j >> 2) + 4 * hi + (j & 3); uf[s][j] = (k >= l31) ? (short)0x3F80 : (short)0; } }
    u32x4 pk_[2], pv_;
    const int krow0 = tid / CPR, kcc0 = tid % CPR, krow1 = ((tid & 255) + 512) / CPR, kcc1 = ((tid & 255) + 512) % CPR;
#define PREFETCH(t) do { const size_t kr_ = (size_t)64 * (t); pk_[0] = *(const u32x4*)(Kh + (kr_ + krow0) * kpitch + kcc0 * 8); \
        if (MODE == 1) pk_[1] = *(const u32x4*)(Kh + (kr_ + krow1) * kpitch + kcc1 * 8); \
        pv_ = *(const u32x4*)(Vh + (size_t)(tid >> 3) * SEQ + kr_ + (tid & 7) * 8); } while (0)
    int done = 0;
    PREFETCH(MODE ? 0 : NT - 1);
    for (int it = 0; it < NT; ++it) {
        const int t = MODE ? it : NT - 1 - it;
        LAS unsigned char* kb = KB + (it & 1) * KBYTES; LAS unsigned char* vbuf = VB + (it & 1) * 9216;
        *(LAS u32x4*)(kb + krow0 * KSTR + kcc0 * 16) = pk_[0];
        if (MODE == 1 && tid < 256) *(LAS u32x4*)(kb + krow1 * KSTR + kcc1 * 16) = pk_[1];
        *(LAS u32x4*)(vbuf + (tid >> 3) * 144 + (tid & 7) * 16) = pv_;
        if (MODE == 0) { if (__syncthreads_and(done)) break; } else __syncthreads();
        if (it + 1 < NT) PREFETCH(MODE ? it + 1 : NT - 2 - it);
#define KFRAG(sub, ks) (*(const LAS bf16x8*)(kb + (32 * (sub) + l31) * KSTR + (16 * (ks) + 8 * hi) * 2))
#define VFRAG(dt, sub, s2) (*(const LAS bf16x8*)(vbuf + (32 * (dt) + l31) * 144 + (32 * (sub) + 16 * (s2) + 8 * hi) * 2))
        if (MODE == 1) {
            if (64 * t <= qw0 + 31) {
                f32x16 s0, s1;
#pragma unroll
                for (int r = 0; r < 16; ++r) { s0[r] = 0.f; s1[r] = 0.f; }
                bf16x8 kf0[NKS], kf1[NKS], vf[8];
#pragma unroll
                for (int ks = 0; ks < NKS; ++ks) { kf0[ks] = KFRAG(0, ks); kf1[ks] = KFRAG(1, ks); }
                __builtin_amdgcn_sched_barrier(0);
#pragma unroll
                for (int ks = 0; ks < NKS; ++ks) { s0 = MFMA32(kf0[ks], qf[ks], s0); s1 = MFMA32(kf1[ks], qf[ks], s1); }
                __builtin_amdgcn_sched_barrier(0);
#pragma unroll
                for (int dt = 0; dt < 2; ++dt) { vf[dt * 4 + 0] = VFRAG(dt, 0, 0); vf[dt * 4 + 1] = VFRAG(dt, 0, 1); vf[dt * 4 + 2] = VFRAG(dt, 1, 0); vf[dt * 4 + 3] = VFRAG(dt, 1, 1); }
                __builtin_amdgcn_sched_barrier(0);
                if (64 * t + 63 > qw0) { const int q = qw0 + l31;
#pragma unroll
                    for (int r = 0; r < 16; ++r) { const int key = 64 * t + crow(r, hi); if (key > q) s0[r] = -INFINITY; if (key + 32 > q) s1[r] = -INFINITY; } }
                float mx = fmaxf(s0[0], s1[0]);
#pragma unroll
                for (int r = 1; r < 16; ++r) mx = fmaxf(mx, fmaxf(s0[r], s1[r]));
                mx = half_max(mx);
                const float mn = fmaxf(mrun, mx), al = fexp2(mrun - mn); mrun = mn;
                float ls = 0.f;
#pragma unroll
                for (int r = 0; r < 16; ++r) { s0[r] = fexp2(s0[r] - mn); s1[r] = fexp2(s1[r] - mn); ls += s0[r] + s1[r]; }
                lrun = lrun * al + ls;
#pragma unroll
                for (int r = 0; r < 16; ++r) { o[0][r] *= al; o[1][r] *= al; }
                const bf16x8 p0 = pack8(s0, 0), p1 = pack8(s0, 1), p2 = pack8(s1, 0), p3 = pack8(s1, 1);
#pragma unroll
                for (int dt = 0; dt < 1; ++dt) { o[0] = MFMA32(vf[0], p0, o[0]); o[1] = MFMA32(vf[4], p0, o[1]); o[0] = MFMA32(vf[1], p1, o[0]); o[1] = MFMA32(vf[5], p1, o[1]);
                    o[0] = MFMA32(vf[2], p2, o[0]); o[1] = MFMA32(vf[6], p2, o[1]); o[0] = MFMA32(vf[3], p3, o[0]); o[1] = MFMA32(vf[7], p3, o[1]); }
            }
        } else {
            const float C2 = 0.125f * 1.4426950408889634f;
#pragma unroll
            for (int sub = 1; sub >= 0; --sub) {
                const int kbase = 64 * t + 32 * sub;
                if (kbase < qw0 + 31) {
                    f32x16 s;
#pragma unroll
                    for (int r = 0; r < 16; ++r) s[r] = 0.f;
                    bf16x8 kfs[NKS], vfs[4];
#pragma unroll
                    for (int ks = 0; ks < NKS; ++ks) kfs[ks] = KFRAG(sub, ks);
                    __builtin_amdgcn_sched_barrier(0);
#pragma unroll
                    for (int ks = 0; ks < NKS; ++ks) s = MFMA32(kfs[ks], qf[ks], s);
                    __builtin_amdgcn_sched_barrier(0);
                    vfs[0] = VFRAG(0, sub, 0); vfs[1] = VFRAG(0, sub, 1); vfs[2] = VFRAG(1, sub, 0); vfs[3] = VFRAG(1, sub, 1);
                    __builtin_amdgcn_sched_barrier(0);
                    const bool need_mask = (kbase + 31 >= qw0); const int q = qw0 + l31;
                    f32x16 lm, rin; float rsum = 0.f;
#pragma unroll
                    for (int r = 0; r < 16; ++r) { const float z2 = s[r] * C2; const float e = fexp2(-fabsf(z2)); float v = -(fmaxf(z2, 0.f) + flog2(1.f + e));
                        const bool valid = !need_mask || (kbase + crow(r, hi) < q);
                        v = valid ? v : 0.f; lm[r] = v; s[r] = valid ? z2 : -INFINITY; rsum += v; rin[r] = R; }
                    f32x16 lo;
                    const bf16x8 h0 = pack8(lm, 0), h1 = pack8(lm, 1);
#pragma unroll
                    for (int r = 0; r < 8; ++r) { lo[r] = lm[r] - __uint_as_float(((unsigned)(unsigned short)h0[r]) << 16); lo[8 + r] = lm[8 + r] - __uint_as_float(((unsigned)(unsigned short)h1[r]) << 16); }
                    const bf16x8 l0 = pack8(lo, 0), l1 = pack8(lo, 1);
                    f32x16 cum = MFMA32(uf[0], h0, rin); cum = MFMA32(uf[1], h1, cum); cum = MFMA32(uf[0], l0, cum); cum = MFMA32(uf[1], l1, cum);
                    rsum = half_sum(rsum); R += rsum;
#pragma unroll
                    for (int r = 0; r < 16; ++r) s[r] = fexp2(s[r] + cum[r]);
                    const bf16x8 p0 = pack8(s, 0), p1 = pack8(s, 1);
#pragma unroll
                    for (int dt = 0; dt < 1; ++dt) { o[0] = MFMA32(vfs[0], p0, o[0]); o[1] = MFMA32(vfs[2], p0, o[1]); o[0] = MFMA32(vfs[1], p1, o[0]); o[1] = MFMA32(vfs[3], p1, o[1]); }
                }
            }
            done = __all(R < -152.0f) ? 1 : 0;
        }
#undef KFRAG
#undef VFRAG
    }
#undef PREFETCH
    float inv = 1.f;
    if (MODE == 1) { lrun = half_sum(lrun); inv = 1.f / lrun; }
#pragma unroll
    for (int dt = 0; dt < 2; ++dt)
#pragma unroll
        for (int r = 0; r < 16; ++r) OST[l31 * 72 + 32 * dt + crow(r, hi)] = f2bf(o[dt][r] * inv);
    asm volatile("s_waitcnt lgkmcnt(0)" ::: "memory");
#pragma unroll
    for (int i = 0; i < 4; ++i) { const int row = i * 8 + (lane >> 3), ch = lane & 7; const u32x4 v = *(const LAS u32x4*)(OST + row * 72 + ch * 8);
        *(u32x4*)(Op + (rowbase + qw0 + row) * opitch + hh * 64 + ch * 8) = v; }
    __syncthreads();
}


#define XB_TMO      128
#define XB_XCNT(j)  (256  + 64 * (j))
#define XB_XSUB(j)  (1280 + 64 * (j))
#define XB_XGEN(j)  (2304 + 64 * (j))
#define XB_TOP      3328
#define XB_TOPGEN   3392
#define XB_SPIN_CAP (1u << 22)
DI unsigned xb_ld(unsigned* p)              { return __hip_atomic_load(p, __ATOMIC_RELAXED, __HIP_MEMORY_SCOPE_AGENT); }
DI unsigned xb_add(unsigned* p, unsigned v) { return __hip_atomic_fetch_add(p, v, __ATOMIC_RELAXED, __HIP_MEMORY_SCOPE_AGENT); }
DI unsigned xb_xcc_id() { return (unsigned)__builtin_amdgcn_s_getreg((3 << 11) | 20) & 0xFu; }
#define XB_SPIN(cond, bar) do { unsigned _sp = 0; while (cond) { __builtin_amdgcn_s_sleep(1); \
    if ((++_sp & 255u) == 0u) { if (xb_ld(&(bar)[XB_TMO])) break; if (_sp > XB_SPIN_CAP) { atomicAdd(&(bar)[XB_TMO], 1u); break; } } } } while (0)
struct XcdBarrier { unsigned* bar; unsigned x; volatile LAS unsigned* st; };
DI XcdBarrier xcd_barrier_post(unsigned* bar, volatile LAS unsigned* st, bool post) {
    XcdBarrier b; b.bar = bar; b.x = xb_xcc_id(); b.st = st;
    if (post && threadIdx.x == 0) (void)xb_add(&bar[XB_XCNT(b.x)], 1u);
    return b;
}
DI void xcd_barrier_complete(unsigned* bar, unsigned x, unsigned& nloc, unsigned& nx) {
    const unsigned G = gridDim.x * gridDim.y * gridDim.z;
    unsigned sum, cnt, mine, sp = 0u;
    for (;;) {
        sum = 0u; cnt = 0u; mine = 0u;
#pragma unroll
        for (unsigned j = 0; j < 16; ++j) { const unsigned cc = xb_ld(&bar[XB_XCNT(j)]); sum += cc; cnt += (cc > 0u) ? 1u : 0u; mine = (j == x) ? cc : mine; }
        if (sum == G) break;
        __builtin_amdgcn_s_sleep(1);
        if ((++sp & 255u) == 0u) { if (xb_ld(&bar[XB_TMO])) break; if (sp > XB_SPIN_CAP) { atomicAdd(&bar[XB_TMO], 1u); break; } }
    }
    nloc = mine > 0u ? mine : 1u; nx = cnt > 0u ? cnt : 1u;
}
DI void xcd_barrier(const XcdBarrier& b) {
    asm volatile("s_waitcnt vmcnt(0)" ::: "memory");
    __syncthreads();
    if (threadIdx.x == 0) {
        unsigned* bar = b.bar;
        __builtin_amdgcn_s_waitcnt(0);
        unsigned nloc = b.st[0], nx = b.st[1];
        if (nloc == 0u) { xcd_barrier_complete(bar, b.x, nloc, nx); b.st[0] = nloc; b.st[1] = nx; }
        const unsigned old = xb_add(&bar[XB_XSUB(b.x)], 1u);
        const unsigned gen = old / nloc;
        if (old + 1u == (gen + 1u) * nloc) {
            __builtin_amdgcn_fence(__ATOMIC_RELEASE, "agent");
            asm volatile("s_waitcnt vmcnt(0)" ::: "memory");
            const unsigned og = xb_add(&bar[XB_TOP], 1u);
            const unsigned tg = og / nx;
            if (og + 1u == (tg + 1u) * nx) xb_add(&bar[XB_TOPGEN], 1u);
            else XB_SPIN(xb_ld(&bar[XB_TOPGEN]) == tg, bar);
            __builtin_amdgcn_fence(__ATOMIC_ACQUIRE, "agent");
            xb_add(&bar[XB_XGEN(b.x)], 1u);
            asm volatile("s_waitcnt vmcnt(0)" ::: "memory");
        } else {
            XB_SPIN(xb_ld(&bar[XB_XGEN(b.x)]) == gen, bar);
            __builtin_amdgcn_fence(__ATOMIC_ACQUIRE, "agent");
            asm volatile("s_waitcnt vmcnt(0)" ::: "memory");
        }
    }
    __syncthreads();
}

struct Args { const float* in[21]; float* out; unsigned char* ws; int ph_lo, ph_hi, rep, pad; };
constexpr int NPHASE = 27;

template <int SP> DI void do_phase(const Ctx& c, const Args& args, const int l, const int rep = 0) {
    unsigned char* ws = args.ws;
    bf16_t* W = (bf16_t*)(ws + WS_W); bf16_t* AB = (bf16_t*)(ws + WS_AB); bf16_t* HB0 = (bf16_t*)(ws + WS_G); bf16_t* HB1 = (bf16_t*)(ws + WS_HB1);
    float* H = args.out;
    const float* ln_g = args.in[17] + (size_t)l * 3 * DM; const float* ln_b = args.in[18] + (size_t)l * 3 * DM;
    LayerW L; L.a1 = args.in[3] + (size_t)l * 1024 * 5632; L.a2 = args.in[4] + (size_t)l * 2816 * 1024; L.mi = args.in[5] + (size_t)l * 1024 * NIN; L.uq = args.in[12] + (size_t)l * 256 * 384;
    L.ukv = args.in[13] + (size_t)l * 128 * 512; L.wo = args.in[14] + (size_t)l * 1024 * 1024; L.b1 = args.in[15] + (size_t)l * 1024 * 5632; L.b2 = args.in[16] + (size_t)l * 2816 * 1024;
    L.gt = args.in[19] + (size_t)l * 1024 * 1024; L.pp = args.in[20] + (size_t)l * 256 * 1024;
    if constexpr (SP == 0) {
        if (l == 0) { cvt_phase(c, args.in[0], HB0, nullptr, (size_t)T_ * DM); rope_phase(c, (const int*)args.in[2], (f32x2*)(ws + WS_ROPE)); }
        conv_phase<0>(c, L, W, c.bid * 8 + c.wid, c.G * 8); }
    else if constexpr (SP == 1 || SP == 9) { pg8::Gemm g{SP == 1 ? (l == 0 ? HB0 : HB1) : HB0, W + (SP == 1 ? OW_A1 : OW_B1), T_, 5632, 1024, 1024}; pg8::StaticOrder S; S.init(T_, 5632, c.G, c.bid);
        pg8::EpiSwiGLU E{AB, DFF}; pg8::gemm_phase<pg8::EpiSwiGLU, pg8::StaticOrder, true>(c.lds, g, S, E);
        if (c.G == 256 && c.bid >= 128) {
            if constexpr (SP == 1) conv_phase<1>(c, L, W, (c.bid - 128) * 8 + c.wid, 128 * 8);
            else { pg8::Gemm g2{(const bf16_t*)(ws + WS_SVT), W + OW_P, T_, 1024, 256, 256}; pg8::StaticOrder S2; S2.init(T_, 1024, 128, c.bid - 128);
                pg8::EpiBf16 E2{(bf16_t*)(ws + WS_MQ), DM}; pg8::gemm_phase<pg8::EpiBf16, pg8::StaticOrder, true>(c.lds, g2, S2, E2); }
        } else if (c.G != 256) {
            if constexpr (SP == 1) conv_phase<1>(c, L, W, c.bid * 8 + c.wid, c.G * 8);
            else { pg8::Gemm g2{(const bf16_t*)(ws + WS_SVT), W + OW_P, T_, 1024, 256, 256}; pg8::StaticOrder S2; S2.init(T_, 1024, c.G, c.bid);
                pg8::EpiBf16 E2{(bf16_t*)(ws + WS_MQ), DM}; pg8::gemm_phase<pg8::EpiBf16, pg8::StaticOrder, true>(c.lds, g2, S2, E2); }
        } }
    else if constexpr (SP == 2 || SP == 10) { pg8::Gemm g{AB, W + (SP == 2 ? OW_A2 : OW_B2), T_, 1024, DFF, DFF}; pg8::StaticOrder S; S.init(T_, 1024, c.G, c.bid);
        pg8::EpiResidLn E{(SP == 2 && l == 0) ? args.in[0] : H, H, HB0, DM, ALPHA, 0.5f, ln_g + (SP == 2 ? 0 : 2 * DM), ln_b + (SP == 2 ? 0 : 2 * DM),
                          (unsigned long long*)(ws + WS_CTL + 524288), (unsigned*)(ws + WS_CTL + 131072) + (l * 3 + (SP == 2 ? 0 : 2)) * 4096};
        pg8::gemm_phase<pg8::EpiResidLn, pg8::StaticOrder, false>(c.lds, g, S, E); }
    else if constexpr (SP == 3) ln_phase(c, H, HB0, ln_g, ln_b);
    else if constexpr (SP == 4) { pg8::Gemm g{HB0, W + OW_MI, T_, NINP, 1024, 1024}; pg8::StaticOrder S; S.init(T_, NINP, c.G, c.bid);
        pg8::EpiBf16 E{AB, NINP}; pg8::gemm_phase<pg8::EpiBf16, pg8::StaticOrder, true>(c.lds, g, S, E);
        LayerW Ln; Ln.a1 = args.in[3] + (size_t)1 * 1024 * 5632; Ln.a2 = args.in[4] + (size_t)1 * 2816 * 1024; Ln.mi = Ln.uq = Ln.ukv = Ln.wo = Ln.b1 = Ln.b2 = Ln.gt = Ln.pp = nullptr;
        if (c.G == 256) { if (c.bid >= 64) { conv_phase<2>(c, L, W, (c.bid - 64) * 8 + c.wid, 192 * 8); if (l == 0) conv_phase<0>(c, Ln, W, (c.bid - 64) * 8 + c.wid, 192 * 8); } }
        else { conv_phase<2>(c, L, W, c.bid * 8 + c.wid, c.G * 8); if (l == 0) conv_phase<0>(c, Ln, W, c.bid * 8 + c.wid, c.G * 8); } }
    else if constexpr (SP == 5) {
        float* GL = (float*)(ws + WS_GL); const f32x2* RT = (const f32x2*)(ws + WS_ROPE);
        if (rep != 2) { u32x4 gx[12]; bf16_t gga = 0, ggb = 0;
            if (c.bid < 2048) gdn_prefetch(c, c.bid, AB, gx, gga, ggb);
            for (int it = c.bid; it < 2048; it += c.G) gdn_prep_item(c, it, it + c.G < 2048 ? it + c.G : it, gx, gga, ggb, AB, args.in[6] + (size_t)l * 4 * 1536, args.in[7] + l * 8, args.in[8] + l * 8, ws + WS_G, GL, rep); }
        if (rep != 1) for (int it = c.bid; it < 256; it += c.G) mla_prep_item(c, it, AB, args.in[10] + l * 256, args.in[11] + l * 128, W + OW_UQ, W + OW_UKV, RT, (bf16_t*)(ws + WS_MQ), (bf16_t*)(ws + WS_MK), (bf16_t*)(ws + WS_MVT), (bf16_t*)(ws + WS_SVT));
    }
    else if constexpr (SP == 6) {
        unsigned* ctl = (unsigned*)(ws + WS_CTL); const float* GL = (const float*)(ws + WS_GL);
        LAS unsigned* qword = (LAS unsigned*)(c.lds + 147000);
#ifndef NO_SCAN
        if (rep != 2) for (int g = c.bid; g < 32; g += c.G) gdn_scan(c, g, ws + WS_G, GL, AB, args.in[9] + l * 64);
#endif
#ifndef NO_ATTN
        if (rep != 1) for (;;) {
            __syncthreads();
            if (c.tid == 0) *qword = atomicAdd(ctl + 64 * (1 + l + 2 * rep), 1u);
            __syncthreads();
            const unsigned u = *qword;
            if (u >= 512u) break;
            const int bh = u & 15, qb = 15 - ((u >> 4) & 15);
            if (u < 256u) attn_unit<1>(c, bh, qb, (const bf16_t*)(ws + WS_MQ), 384, (const bf16_t*)(ws + WS_MK), 384, (const bf16_t*)(ws + WS_MVT), AB + 768, NINP);
#ifndef NO_SB
            else attn_unit<0>(c, bh, qb, AB + C_SQ, NINP, AB + C_SK, NINP, (const bf16_t*)(ws + WS_SVT), AB + 512, NINP);
#endif
        }
#endif
    }
    else if constexpr (SP == 7) { pg8::Gemm g{AB, W + OW_O, T_, 1024, 1024, NINP}; pg8::StaticOrder S; S.init(T_, 1024, c.G, c.bid);
        pg8::EpiResidLn E{H, H, HB0, DM, ALPHA, 1.0f, ln_g + DM, ln_b + DM, (unsigned long long*)(ws + WS_CTL + 524288), (unsigned*)(ws + WS_CTL + 131072) + (l * 3 + 1) * 4096};
        pg8::gemm_phase<pg8::EpiResidLn, pg8::StaticOrder, false>(c.lds, g, S, E);
        cvt_phase(c, args.in[1] + (size_t)l * T_ * 256, (bf16_t*)(ws + WS_SVT), nullptr, (size_t)T_ * 256); }
    else if constexpr (SP == 8) { ln_phase(c, H, HB0, ln_g + DM, ln_b + DM); cvt_phase(c, args.in[1] + (size_t)l * T_ * 256, (bf16_t*)(ws + WS_PB), nullptr, (size_t)T_ * 256); }
    else if constexpr (SP == 11) { pg8::Gemm g{(const bf16_t*)(ws + WS_SVT), W + OW_P, T_, 1024, 256, 256}; pg8::StaticOrder S; S.init(T_, 1024, c.G, c.bid);
        pg8::EpiBf16 E{(bf16_t*)(ws + WS_MQ), DM}; pg8::gemm_phase<pg8::EpiBf16, pg8::StaticOrder, true>(c.lds, g, S, E); }
    else if constexpr (SP == 12) { pg8::Gemm g{HB0, W + OW_GT, T_, 1024, 1024, 1024}; pg8::StaticOrder S; S.init(T_, 1024, c.G, c.bid);
        pg8::EpiPle E{H, (const bf16_t*)(ws + WS_MQ), HB1, DM}; pg8::gemm_phase<pg8::EpiPle, pg8::StaticOrder, true>(c.lds, g, S, E); }
}

#ifndef SPMASK
#define SPMASK 0x16f7
#endif
#ifndef PROBE_REP
#define PROBE_REP 1
#endif
#ifndef PROBE_SPMASK
#define PROBE_SPMASK 0
#endif
__global__ void __launch_bounds__(512, 2) mk_fwd(Args args) {
    extern __shared__ __attribute__((aligned(16))) unsigned char lds_raw[];
    Ctx c; c.lds = (LAS unsigned char*)lds_raw; c.tid = threadIdx.x; c.lane = c.tid & 63; c.wid = __builtin_amdgcn_readfirstlane(c.tid >> 6); c.G = gridDim.x; c.bid = blockIdx.x;
    cg::grid_group grid = cg::this_grid();
    const int lo = args.ph_lo, hi = args.ph_hi;
    volatile LAS unsigned* xst = (volatile LAS unsigned*)(c.lds + 147008);
    if (c.tid == 0) { xst[0] = 0u; xst[1] = 0u; }
    __syncthreads();
    const XcdBarrier xbar = xcd_barrier_post((unsigned*)(args.ws + WS_CTL) + 1024, xst, hi - lo > 1);
    if (lo < 0) grid.sync();
#define SEAM(idx) if ((idx) > lo && (idx) > 1) { xcd_barrier(xbar); }
#define PH(L, SP) if (((SPMASK >> SP) & 1) && lo <= 1 + 13 * L + SP && 1 + 13 * L + SP < hi) { SEAM(1 + 13 * L + SP) do_phase<SP>(c, args, L, args.rep); }
    PH(0, 0) PH(0, 1) PH(0, 2) PH(0, 3) PH(0, 4) PH(0, 5) PH(0, 6) PH(0, 7) PH(0, 8) PH(0, 9) PH(0, 10) PH(0, 11) PH(0, 12)
      PH(1, 1) PH(1, 2) PH(1, 3) PH(1, 4) PH(1, 5) PH(1, 6) PH(1, 7) PH(1, 8) PH(1, 9) PH(1, 10) PH(1, 11) PH(1, 12)
#undef PH
#undef SEAM
}

extern "C" void kernel_launch(void* const* d_in, const int* in_sizes, int n_in, void* d_out, int out_size, void* d_ws, size_t ws_size, hipStream_t stream) {
    static int grid = 0;
    if (grid == 0) {
        if (n_in != 21 || out_size != T_ * DM || ws_size < WS_END) { fprintf(stderr, "kernel_launch: unexpected shapes (n_in %d out %d ws %zu)\n", n_in, out_size, ws_size); grid = -1; return; }
        int dev = 0, cus = 0, per_cu = 0;
        hipGetDevice(&dev); hipDeviceGetAttribute(&cus, hipDeviceAttributeMultiprocessorCount, dev);
        if (hipFuncSetAttribute((const void*)mk_fwd, hipFuncAttributeMaxDynamicSharedMemorySize, LDS_BYTES) != hipSuccess) { fprintf(stderr, "kernel_launch: hipFuncSetAttribute failed\n"); grid = -1; return; }
        if (hipOccupancyMaxActiveBlocksPerMultiprocessor(&per_cu, (const void*)mk_fwd, 512, LDS_BYTES) != hipSuccess || per_cu < 1) { fprintf(stderr, "kernel_launch: occupancy query %d\n", per_cu); per_cu = 1; }
        (void)hipGetLastError();
        grid = cus * 1;
    }
    if (grid < 0) return;
    hipMemsetAsync((char*)d_ws + WS_CTL, 0, 262144, stream);
    Args a{};
    for (int i = 0; i < 21; ++i) a.in[i] = (const float*)d_in[i];
    a.out = (float*)d_out; a.ws = (unsigned char*)d_ws;
#if MK_ONE_LAUNCH
    a.ph_lo = 0; a.ph_hi = NPHASE;
    void* kargs[] = {&a};
    hipError_t e = hipLaunchCooperativeKernel((const void*)mk_fwd, dim3(grid), dim3(512), kargs, LDS_BYTES, stream);
    if (e != hipSuccess) fprintf(stderr, "cooperative launch failed: %s (grid %d)\n", hipGetErrorString(e), grid);
#else
    for (int ph = 0; ph < NPHASE; ++ph) { a.ph_lo = ph; a.ph_hi = ph + 1; a.rep = 0; hipLaunchKernelGGL(mk_fwd, dim3(grid), dim3(512), LDS_BYTES, stream, a);
        if (ph >= 1 && ((PROBE_SPMASK >> ((ph - 1) % 13)) & 1)) { a.rep = PROBE_REP; hipLaunchKernelGGL(mk_fwd, dim3(grid), dim3(512), LDS_BYTES, stream, a); } }
#endif
}
```

```cpp
#include <hip/hip_runtime.h>
#include <hip/hip_cooperative_groups.h>
#include <cstdio>
#include <cstdint>
namespace cg = cooperative_groups;

#ifndef MK_ONE_LAUNCH
#define MK_ONE_LAUNCH 1
#endif

#define LAS __attribute__((address_space(3)))
#define DI __device__ __forceinline__
typedef unsigned short bf16_t;
typedef short bf16x8 __attribute__((ext_vector_type(8)));
typedef float f32x4 __attribute__((ext_vector_type(4)));
typedef float f32x2 __attribute__((ext_vector_type(2)));
typedef float f32x16 __attribute__((ext_vector_type(16)));
typedef unsigned u32x4 __attribute__((ext_vector_type(4)));
typedef unsigned u32x2 __attribute__((ext_vector_type(2)));

DI unsigned pk2(float lo, float hi) { typedef __bf16 b2 __attribute__((ext_vector_type(2))); f32x2 v = {lo, hi}; b2 b = __builtin_convertvector(v, b2); return __builtin_bit_cast(unsigned, b); }
DI float bflo(unsigned w) { return __uint_as_float(w << 16); }
DI float bfhi(unsigned w) { return __uint_as_float(w & 0xffff0000u); }
DI float bf2f(bf16_t u) { return __uint_as_float(((unsigned)u) << 16); }
DI bf16_t f2bf(float f) { return (bf16_t)(pk2(f, 0.f) & 0xffffu); }
DI float wave_sum(float v) {
#pragma unroll
    for (int o = 1; o < 64; o <<= 1) v += __shfl_xor(v, o);
    return v;
}
DI float fexp2(float x) { return __builtin_amdgcn_exp2f(x); }
DI float flog2(float x) { return __builtin_amdgcn_logf(x); }
DI float frcp(float x) { return __builtin_amdgcn_rcpf(x); }
DI float silu_f(float g) { return g * frcp(1.f + fexp2(-1.4426950408889634f * g)); }
DI float sigmoid_f(float g) { return frcp(1.f + fexp2(-1.4426950408889634f * g)); }
#define LBAR() do { asm volatile("s_waitcnt lgkmcnt(0)" ::: "memory"); __builtin_amdgcn_s_barrier(); asm volatile("" ::: "memory"); } while (0)
DI float half_sum(float v) { const unsigned u = __float_as_uint(v); auto rr = __builtin_amdgcn_permlane32_swap(u, u, false, false); return __uint_as_float(rr[0]) + __uint_as_float(rr[1]); }
DI float half_max(float v) { const unsigned u = __float_as_uint(v); auto rr = __builtin_amdgcn_permlane32_swap(u, u, false, false); return fmaxf(__uint_as_float(rr[0]), __uint_as_float(rr[1])); }
DI int crow(int r, int hi) { return (r & 3) + 8 * (r >> 2) + 4 * hi; }
#define MFMA32(a, b, c) __builtin_amdgcn_mfma_f32_32x32x16_bf16((a), (b), (c), 0, 0, 0)
#define MFMA16(a, b, c) __builtin_amdgcn_mfma_f32_16x16x32_bf16((a), (b), (c), 0, 0, 0)
DI bf16x8 pack8(const f32x16& x, int s) {
    u32x4 p;
    p.x = pk2(x[8 * s + 0], x[8 * s + 1]); p.y = pk2(x[8 * s + 2], x[8 * s + 3]); p.z = pk2(x[8 * s + 4], x[8 * s + 5]); p.w = pk2(x[8 * s + 6], x[8 * s + 7]);
    return __builtin_bit_cast(bf16x8, p);
}

constexpr int T_ = 16384, DM = 1024, SEQ = 4096, DFF = 2816, NIN = 3248, NINP = 3328;
constexpr float ALPHA = 1.4142135623730951f;
constexpr float LN_EPS = 1e-5f;
constexpr int C_GZ = 1536, C_GA = 2048, C_GB = 2056, C_SQ = 2064, C_SK = 2320, C_SV = 2576, C_MQ = 2832, C_CKV = 3088, C_KR = 3216;
constexpr size_t MiB = 1u << 20;
constexpr size_t WS_CTL = 0, WS_GL = 65536, WS_ROPE = 1 * MiB, WS_W = 3 * MiB, WS_AB = 48 * MiB, WS_G = 152 * MiB, WS_MQ = 232 * MiB, WS_MK = 244 * MiB, WS_MVT = 256 * MiB, WS_SVT = 264 * MiB, WS_END = 272 * MiB;
constexpr size_t WS_HB1 = WS_G + 32 * MiB, WS_PB = WS_AB + 96 * MiB;
constexpr size_t OW_A1 = 0, OW_A2 = 5767168, OW_B1 = 8650752, OW_B2 = 14417920, OW_MI = 17301504, OW_UQ = 20709376, OW_UKV = 20807680, OW_O = 20873216, OW_GT = 21921792, OW_P = 22970368;
constexpr int LDS_BYTES = 147456;
constexpr int GSLOT = 40960;

namespace pg8 {
constexpr int BM = 256, BK = 64, HALF = 128, HTB = HALF * BK * 2, STAGE_BYTES = 8 * HTB, NXCD = 8, WGM = 8;
DI int lds_byte(int r, int c) { const int st = (r >> 4) * 2 + (c >> 5), rr = r & 15, cc = c & 31, ob = rr * 64 + cc * 2; return st * 1024 + (ob ^ (((ob >> 9) & 1) << 5)); }
DI void stage_rc(int b, int& R, int& C) { const int st = b / 1024, sb = b % 1024, swz = sb ^ (((sb >> 9) & 1) << 5); R = (st >> 1) * 16 + swz / 64; C = (st & 1) * 32 + (swz % 64) / 2; }
DI int perm32(int rho) { const int n = rho >> 4, i = rho & 15; return 8 * (i >> 2) + 4 * n + (i & 3); }
struct Unit { int pm, pn; };
struct Gemm { const bf16_t* A; const bf16_t* Bt; int M, N, K, lda; };
struct StaticOrder {
    int nM, nN, nwg, G, c;
    DI void init(int M, int N, int G_, int c_) { nM = M / BM; nN = N / BM; nwg = nM * nN; G = G_; c = c_; }
    DI bool next(int i, Unit& u) const {
        const long L = (long)i * G + c; if (L >= nwg) return false;
        int wgid = (int)L; { const int q = nwg / NXCD, r = nwg % NXCD, xcd = wgid % NXCD, off = wgid / NXCD; wgid = (xcd < r ? xcd * (q + 1) : r * (q + 1) + (xcd - r) * q) + off; }
        const int nig = WGM * nN, gid = wgid / nig, fm = gid * WGM, gsz = (nM - fm) < WGM ? (nM - fm) : WGM;
        u.pm = fm + ((wgid % nig) % gsz); u.pn = (wgid % nig) / gsz; return true;
    }
};
struct EpiBf16 {
    static constexpr bool PERM = true, AFTER_DRAIN = false;
    bf16_t* O; int ldc;
    DI void operator()(const f32x4 (&acc)[2][2][4][2], const Unit& u, int wr, int wc, int fr, int fq) const {
        const int row0 = u.pm * BM + wr * 64 + fr; const int col0 = u.pn * BM + wc * 32 + 8 * fq;
#pragma unroll
        for (int ai = 0; ai < 2; ++ai)
#pragma unroll
            for (int m = 0; m < 4; ++m) { bf16_t* rowp = O + (size_t)(row0 + ai * HALF + m * 16) * ldc + col0;
#pragma unroll
                for (int bj = 0; bj < 2; ++bj) { const f32x4 v0 = acc[ai][bj][m][0], v1 = acc[ai][bj][m][1];
                    u32x4 w; w.x = pk2(v0[0], v0[1]); w.y = pk2(v0[2], v0[3]); w.z = pk2(v1[0], v1[1]); w.w = pk2(v1[2], v1[3]);
                    *(u32x4*)(rowp + bj * HALF) = w; } }
    }
};
struct EpiSwiGLU {
    static constexpr bool PERM = true, AFTER_DRAIN = false;
    bf16_t* O; int ldc;
    DI void operator()(const f32x4 (&acc)[2][2][4][2], const Unit& u, int wr, int wc, int fr, int fq) const {
        const int row0 = u.pm * BM + wr * 64 + fr; const int col0 = u.pn * HALF + wc * 32 + 8 * fq;
#pragma unroll
        for (int ai = 0; ai < 2; ++ai)
#pragma unroll
            for (int m = 0; m < 4; ++m) { bf16_t* rowp = O + (size_t)(row0 + ai * HALF + m * 16) * ldc + col0;
                float v[8];
#pragma unroll
                for (int n = 0; n < 2; ++n)
#pragma unroll
                    for (int e = 0; e < 4; ++e) v[4 * n + e] = silu_f(acc[ai][0][m][n][e]) * acc[ai][1][m][n][e];
                u32x4 w; w.x = pk2(v[0], v[1]); w.y = pk2(v[2], v[3]); w.z = pk2(v[4], v[5]); w.w = pk2(v[6], v[7]);
                *(u32x4*)rowp = w; }
    }
};
struct EpiResid {
    static constexpr bool PERM = false, AFTER_DRAIN = false;
    const float* Hin; float* H; int ldc; float alpha, s;
    DI void operator()(const f32x4 (&acc)[2][2][4][2], const Unit& u, int wr, int wc, int fr, int fq) const {
        const int col0 = u.pn * BM + wc * 32 + 4 * fq;
#pragma unroll
        for (int ai = 0; ai < 2; ++ai)
#pragma unroll
            for (int m = 0; m < 4; ++m) { const int r = u.pm * BM + ai * HALF + wr * 64 + m * 16 + fr; const size_t ro = (size_t)r * ldc + col0;
#pragma unroll
                for (int bj = 0; bj < 2; ++bj)
#pragma unroll
                    for (int n = 0; n < 2; ++n) { const f32x4 h = *(const f32x4*)(Hin + ro + bj * HALF + n * 16); *(f32x4*)(H + ro + bj * HALF + n * 16) = h * alpha + acc[ai][bj][m][n] * s; } }
    }
};
struct EpiPle {
    static constexpr bool PERM = false, AFTER_DRAIN = false;
    float* H; const bf16_t* PP; bf16_t* HB; int ldc;
    DI void operator()(const f32x4 (&acc)[2][2][4][2], const Unit& u, int wr, int wc, int fr, int fq) const {
        const int col0 = u.pn * BM + wc * 32 + 4 * fq;
#pragma unroll
        for (int ai = 0; ai < 2; ++ai)
#pragma unroll
            for (int m = 0; m < 4; ++m) { const int r = u.pm * BM + ai * HALF + wr * 64 + m * 16 + fr; const size_t ro = (size_t)r * ldc + col0;
#pragma unroll
                for (int bj = 0; bj < 2; ++bj)
#pragma unroll
                    for (int n = 0; n < 2; ++n) { const size_t off = ro + bj * HALF + n * 16; f32x4* p = (f32x4*)(H + off); const f32x4 h = *p; const u32x2 pw = *(const u32x2*)(PP + off);
                        const f32x4 a = acc[ai][bj][m][n]; f32x4 o;
                        o[0] = h[0] + sigmoid_f(a[0]) * bflo(pw.x); o[1] = h[1] + sigmoid_f(a[1]) * bfhi(pw.x); o[2] = h[2] + sigmoid_f(a[2]) * bflo(pw.y); o[3] = h[3] + sigmoid_f(a[3]) * bfhi(pw.y);
                        *p = o; u32x2 w; w.x = pk2(o[0], o[1]); w.y = pk2(o[2], o[3]); *(u32x2*)(HB + off) = w; } }
    }
};

struct EpiResidLn {
    static constexpr bool PERM = false, AFTER_DRAIN = true;
    const float* Hin; float* H; bf16_t* HB; int ldc; float alpha, s; const float* g; const float* b;
    unsigned long long* xbuf; unsigned* cnt;
    DI void fused(f32x4 (&acc)[2][2][4][2], const Unit& u, int wr, int wc, int fr_, int fq_, LAS unsigned char* lds, int wid, int lane_) const {
        int lane = lane_; asm volatile("" : "+v"(lane));
        const int fr = lane & 15, fq = lane >> 4;
        LAS f32x2* P = (LAS f32x2*)lds;
        LAS f32x2* S = (LAS f32x2*)(lds + 8192);
        const int col0 = u.pn * BM + wc * 32 + 4 * fq;
#pragma unroll
        for (int ai = 0; ai < 2; ++ai)
#pragma unroll
            for (int m = 0; m < 4; ++m) { const int r = u.pm * BM + ai * HALF + wr * 64 + m * 16 + fr; const size_t ro = (size_t)r * ldc + col0;
#pragma unroll
                for (int bj = 0; bj < 2; ++bj)
#pragma unroll
                    for (int n = 0; n < 2; ++n) { const f32x4 h = *(const f32x4*)(Hin + ro + bj * HALF + n * 16); acc[ai][bj][m][n] = h * alpha + acc[ai][bj][m][n] * s; }
                asm volatile("" : "+v"(acc[ai][0][m][0]), "+v"(acc[ai][0][m][1]), "+v"(acc[ai][1][m][0]), "+v"(acc[ai][1][m][1]));
                asm volatile("" ::: "memory"); }
#pragma unroll
        for (int ai = 0; ai < 2; ++ai)
#pragma unroll
            for (int m = 0; m < 4; ++m) {
                float sm = 0.f;
#pragma unroll
                for (int bj = 0; bj < 2; ++bj)
#pragma unroll
                    for (int n = 0; n < 2; ++n) { const f32x4 x = acc[ai][bj][m][n]; sm += (x[0] + x[1]) + (x[2] + x[3]); }
                sm += __shfl_xor(sm, 16); sm += __shfl_xor(sm, 32);
                const float mw = sm * (1.0f / 64.0f); float q = 0.f;
#pragma unroll
                for (int bj = 0; bj < 2; ++bj)
#pragma unroll
                    for (int n = 0; n < 2; ++n) { const f32x4 d = acc[ai][bj][m][n] - mw; q += (d[0] * d[0] + d[1] * d[1]) + (d[2] * d[2] + d[3] * d[3]); }
                q += __shfl_xor(q, 16); q += __shfl_xor(q, 32);
                if (fq == 0) P[(ai * HALF + wr * 64 + m * 16 + fr) * 4 + wc] = (f32x2){mw, q};
                __builtin_amdgcn_sched_barrier(0);
            }
        asm volatile("s_waitcnt lgkmcnt(0)" ::: "memory"); __builtin_amdgcn_s_barrier(); asm volatile("" ::: "memory");
        const int row = wid * 32 + (lane & 31);
        if (lane < 32) {
            const f32x2 a = P[row * 4 + 0], bb = P[row * 4 + 1], cc = P[row * 4 + 2], dd = P[row * 4 + 3];
            const float mt = (a[0] + bb[0] + cc[0] + dd[0]) * 0.25f;
            const float da = a[0] - mt, db = bb[0] - mt, dc = cc[0] - mt, de = dd[0] - mt;
            const float m2 = (a[1] + bb[1]) + (cc[1] + dd[1]) + 64.0f * ((da * da + db * db) + (dc * dc + de * de));
            unsigned long long* slot = xbuf + ((size_t)(u.pm * BM + row) * 4 + u.pn);
            __hip_atomic_store(slot, ((unsigned long long)__float_as_uint(m2) << 32) | __float_as_uint(mt), __ATOMIC_RELAXED, __HIP_MEMORY_SCOPE_AGENT);
        }
        asm volatile("s_waitcnt vmcnt(0)" ::: "memory");
        if (lane == 0) __hip_atomic_fetch_add(cnt + 64 * u.pm, 1u, __ATOMIC_RELAXED, __HIP_MEMORY_SCOPE_AGENT);
        if (wid == 0) {
            unsigned spins = 0;
            while ((unsigned)__builtin_amdgcn_readfirstlane(__hip_atomic_load(cnt + 64 * u.pm, __ATOMIC_RELAXED, __HIP_MEMORY_SCOPE_AGENT)) < 32u) { __builtin_amdgcn_s_sleep(2); if (++spins > (1u << 22)) break; }
            __builtin_amdgcn_fence(__ATOMIC_ACQUIRE, "agent");
        }
        asm volatile("s_waitcnt vmcnt(0) lgkmcnt(0)" ::: "memory"); __builtin_amdgcn_s_barrier(); asm volatile("" ::: "memory");
        if (lane < 32) {
            const unsigned long long* slot = xbuf + (size_t)(u.pm * BM + row) * 4; float mt[4], m2[4]; float ms = 0.f;
#pragma unroll
            for (int t = 0; t < 4; ++t) { const unsigned long long w = __hip_atomic_load(slot + t, __ATOMIC_RELAXED, __HIP_MEMORY_SCOPE_AGENT); mt[t] = __uint_as_float((unsigned)w); m2[t] = __uint_as_float((unsigned)(w >> 32)); ms += mt[t]; }
            const float mean = ms * 0.25f; float q = 0.f;
#pragma unroll
            for (int t = 0; t < 4; ++t) { const float dm = mt[t] - mean; q += m2[t] + 256.0f * dm * dm; }
            S[row] = (f32x2){mean, __builtin_amdgcn_rsqf(q * (1.0f / 1024.0f) + LN_EPS)};
        }
        asm volatile("s_waitcnt lgkmcnt(0)" ::: "memory"); __builtin_amdgcn_s_barrier(); asm volatile("" ::: "memory");
#pragma unroll
        for (int ai = 0; ai < 2; ++ai)
#pragma unroll
            for (int m = 0; m < 4; ++m) { const int rl = ai * HALF + wr * 64 + m * 16 + fr; const f32x2 sr = S[rl]; const size_t ro = (size_t)(u.pm * BM + rl) * ldc + col0;
#pragma unroll
                for (int bj = 0; bj < 2; ++bj)
#pragma unroll
                    for (int n = 0; n < 2; ++n) { const f32x4 gv = *(const f32x4*)(g + col0 + bj * HALF + n * 16), bv = *(const f32x4*)(b + col0 + bj * HALF + n * 16);
                        const f32x4 o = (acc[ai][bj][m][n] - sr[0]) * sr[1] * gv + bv;
                        *(f32x4*)(H + ro + bj * HALF + n * 16) = o; u32x2 w; w.x = pk2(o[0], o[1]); w.y = pk2(o[2], o[3]); *(u32x2*)(HB + ro + bj * HALF + n * 16) = w; }
                __builtin_amdgcn_sched_barrier(0); }
    }
};

template <class Epi, class Sched, bool ALIGN_EPI>
DI void gemm_phase(LAS unsigned char* lds, const Gemm g, const Sched& S, const Epi& E) {
    const int tid = threadIdx.x, wid = __builtin_amdgcn_readfirstlane(tid >> 6), lane = tid & 63, wr = wid >> 2, wc = wid & 3, fr = lane & 15, fq = lane >> 4;
    const int K = g.K, nt = K / BK, lda = g.lda;
    unsigned voffA[2], voffB[2];
#pragma unroll
    for (int i = 0; i < 2; ++i) { int R, C; stage_rc(tid * 16 + i * 8192, R, C); const int Rb = Epi::PERM ? ((R & ~31) + perm32(R & 31)) : R;
        voffA[i] = (unsigned)(R * lda + C) * 2u; voffB[i] = (unsigned)(Rb * K + C) * 2u; }
    const size_t kstep = (size_t)(BK * 2);
    const size_t hstepA = (size_t)HALF * lda * 2, tstepA = 2 * hstepA;
    const size_t hstepB = (size_t)HALF * K * 2, tstepB = 2 * hstepB;
    const unsigned ldsw = (unsigned)wid * 1024u;
    const int aoff = lds_byte(wr * 64 + fr, fq * 8), boff = lds_byte(wc * 32 + fr, fq * 8);
#define PG8_SA(b, h) (((b) * 2 + (h)) * HTB)
#define PG8_SB(b, h) ((4 + (b) * 2 + (h)) * HTB)
#define PG8_STAGE(bufoff, gbase, voff) do { _Pragma("unroll") for (int _i = 0; _i < 2; ++_i) \
        __builtin_amdgcn_global_load_lds((const unsigned*)((const char*)(gbase) + (voff)[_i]), (LAS unsigned*)(lds + (bufoff) + ldsw + _i * 8192), 16, 0, 0); } while (0)
#define PG8_LDA(dst, b, h) do { _Pragma("unroll") for (int m = 0; m < 4; ++m) _Pragma("unroll") for (int k = 0; k < 2; ++k) dst[m][k] = *(const LAS bf16x8*)(lds + PG8_SA(b, h) + aoff + m * 2048 + k * 1024); } while (0)
#define PG8_LDB(dst, b, h) do { _Pragma("unroll") for (int n = 0; n < 2; ++n) _Pragma("unroll") for (int k = 0; k < 2; ++k) dst[n][k] = *(const LAS bf16x8*)(lds + PG8_SB(b, h) + boff + n * 2048 + k * 1024); } while (0)
#define PG8_MMA(ai, bj, At, Bt) do { __builtin_amdgcn_s_setprio(1); _Pragma("unroll") for (int m = 0; m < 4; ++m) _Pragma("unroll") for (int n = 0; n < 2; ++n) _Pragma("unroll") for (int k = 0; k < 2; ++k) \
        acc[ai][bj][m][n] = __builtin_amdgcn_mfma_f32_16x16x32_bf16(Bt[n][k], At[m][k], acc[ai][bj][m][n], 0, 0, 0); __builtin_amdgcn_s_setprio(0); } while (0)
#define PG8_WAIT_V(n) asm volatile("s_waitcnt vmcnt(" #n ")" ::: "memory")
#define PG8_WAIT_L(n) asm volatile("s_waitcnt lgkmcnt(" #n ")" ::: "memory")
#define PG8_BAR __builtin_amdgcn_s_barrier()
#define PG8_SCHED __builtin_amdgcn_sched_barrier(0)
    Unit cur, nxt; int ui = 0;
    if (!S.next(0, cur)) return;
    f32x4 acc[2][2][4][2];
#pragma unroll
    for (int a = 0; a < 2; ++a)
#pragma unroll
        for (int b = 0; b < 2; ++b)
#pragma unroll
            for (int m = 0; m < 4; ++m)
#pragma unroll
                for (int n = 0; n < 2; ++n) acc[a][b][m][n] = (f32x4){0.f, 0.f, 0.f, 0.f};
    bf16x8 At[4][2], B0[2][2], B1[2][2];
    const char* cA = (const char*)g.A + (size_t)cur.pm * tstepA; const char* cB = (const char*)g.Bt + (size_t)cur.pn * tstepB;
    PG8_STAGE(PG8_SB(0, 0), cB, voffB); PG8_STAGE(PG8_SB(0, 1), cB + hstepB, voffB); PG8_STAGE(PG8_SA(0, 0), cA, voffA); PG8_STAGE(PG8_SA(0, 1), cA + hstepA, voffA);
    if (wr == 1) PG8_BAR;
    PG8_WAIT_V(2); PG8_BAR;
    PG8_STAGE(PG8_SB(1, 0), cB + kstep, voffB); PG8_STAGE(PG8_SA(1, 0), cA + kstep, voffA); PG8_STAGE(PG8_SB(1, 1), cB + hstepB + kstep, voffB);
    PG8_WAIT_V(6); PG8_BAR;
    for (;;) {
        const bool has_next = S.next(ui + 1, nxt);
        const char* nA = has_next ? (const char*)g.A + (size_t)nxt.pm * tstepA : cA; const char* nB = has_next ? (const char*)g.Bt + (size_t)nxt.pn * tstepB : cB;
        for (int t = 0; t < nt; t += 2) {
            const bool last = (t == nt - 2);
            const char* a1 = cA + (size_t)(t + 1) * kstep;
            const char* a2 = last ? nA : cA + (size_t)(t + 2) * kstep; const char* b2 = last ? nB : cB + (size_t)(t + 2) * kstep;
            const char* a3 = a2 + kstep; const char* b3 = b2 + kstep;
            PG8_LDB(B0, 0, 0); PG8_LDB(B1, 0, 1); PG8_SCHED; PG8_LDA(At, 0, 0); PG8_STAGE(PG8_SA(1, 1), a1 + hstepA, voffA);
            PG8_WAIT_V(8); PG8_WAIT_L(0); PG8_BAR; PG8_MMA(0, 0, At, B0); PG8_MMA(0, 1, At, B1); PG8_BAR; PG8_SCHED;
            PG8_LDA(At, 0, 1); PG8_STAGE(PG8_SB(0, 0), b2, voffB); PG8_STAGE(PG8_SB(0, 1), b2 + hstepB, voffB); PG8_STAGE(PG8_SA(0, 0), a2, voffA);
            PG8_WAIT_V(8); PG8_WAIT_L(0); PG8_BAR; PG8_MMA(1, 0, At, B0); PG8_MMA(1, 1, At, B1); PG8_BAR; PG8_SCHED;
            PG8_LDB(B0, 1, 0); PG8_LDB(B1, 1, 1); PG8_SCHED; PG8_LDA(At, 1, 0); PG8_STAGE(PG8_SA(0, 1), a2 + hstepA, voffA);
            PG8_WAIT_V(8); PG8_WAIT_L(0); PG8_BAR; PG8_MMA(0, 0, At, B0); PG8_MMA(0, 1, At, B1); PG8_BAR; PG8_SCHED;
            PG8_LDA(At, 1, 1); PG8_STAGE(PG8_SB(1, 0), b3, voffB); PG8_STAGE(PG8_SB(1, 1), b3 + hstepB, voffB); PG8_STAGE(PG8_SA(1, 0), a3, voffA);
            PG8_WAIT_V(8); PG8_WAIT_L(0); PG8_BAR; PG8_MMA(1, 0, At, B0); PG8_MMA(1, 1, At, B1); PG8_BAR; PG8_SCHED;
        }
        if constexpr (ALIGN_EPI) { if (wr == 0) PG8_BAR; }
        if constexpr (!Epi::AFTER_DRAIN) E(acc, cur, wr, wc, fr, fq);
        if (!has_next) break;
#pragma unroll
        for (int a = 0; a < 2; ++a)
#pragma unroll
            for (int b = 0; b < 2; ++b)
#pragma unroll
                for (int m = 0; m < 4; ++m)
#pragma unroll
                    for (int n = 0; n < 2; ++n) acc[a][b][m][n] = (f32x4){0.f, 0.f, 0.f, 0.f};
        cur = nxt; cA = nA; cB = nB; ++ui;
        if constexpr (ALIGN_EPI) { if (wr == 1) PG8_BAR; }
    }
    PG8_WAIT_V(0);
    if constexpr (!ALIGN_EPI) { if (wr == 0) PG8_BAR; }
    PG8_BAR;
    if constexpr (Epi::AFTER_DRAIN) E.fused(acc, cur, wr, wc, fr, fq, lds, wid, lane);
#undef PG8_SA
#undef PG8_SB
#undef PG8_STAGE
#undef PG8_LDA
#undef PG8_LDB
#undef PG8_MMA
#undef PG8_WAIT_V
#undef PG8_WAIT_L
#undef PG8_BAR
#undef PG8_SCHED
}
}

struct Ctx { LAS unsigned char* lds; int tid, lane, wid, G, bid; };

DI void conv_item(const float* W, int K, int Nsrc, bf16_t* WT, int mode, LAS float* scr, int item, int nblk, int lane) {
    const int kb = item / nblk, nb = item % nblk, k0 = 64 * kb, n0 = 32 * nb;
    const int n = n0 + (lane & 31);
    int src = n; bool ok = n < Nsrc;
    if (mode == 1) { const int pn = n >> 8, bj = (n >> 7) & 1, jj = n & 127; src = bj * DFF + pn * 128 + jj; ok = true; }
    float wv[32];
    const int srcc = ok ? src : 0;
#pragma unroll
    for (int i = 0; i < 32; ++i) { const int kk = 2 * i + (lane >> 5); wv[i] = W[(size_t)(k0 + kk) * Nsrc + srcc]; }
#pragma unroll
    for (int i = 0; i < 32; ++i) { const int kk = 2 * i + (lane >> 5); scr[kk * 33 + (lane & 31)] = ok ? wv[i] : 0.f; }
    asm volatile("s_waitcnt lgkmcnt(0)" ::: "memory");
    const int c = lane & 7;
#pragma unroll
    for (int j = 0; j < 4; ++j) { const int nn = (lane >> 3) + 8 * j; const LAS float* s = scr + (8 * c) * 33 + nn;
        u32x4 o; o.x = pk2(s[0 * 33], s[1 * 33]); o.y = pk2(s[2 * 33], s[3 * 33]); o.z = pk2(s[4 * 33], s[5 * 33]); o.w = pk2(s[6 * 33], s[7 * 33]);
        *(u32x4*)(WT + (size_t)(n0 + nn) * K + k0 + 8 * c) = o; }
    asm volatile("s_waitcnt lgkmcnt(0)" ::: "memory");
}

struct LayerW { const float *a1, *a2, *mi, *uq, *ukv, *wo, *b1, *b2, *gt, *pp; };
template <int SET> DI void conv_phase(const Ctx& c, const LayerW& L, bf16_t* W, const int gw, const int NGW) {
    LAS float* scr = (LAS float*)(c.lds + c.wid * 8448);
    constexpr int I_A1 = 16 * 176, I_A2 = 44 * 32, I_MI = 16 * 104, I_UQ = 4 * 12, I_UKV = 2 * 16, I_O = 16 * 32, I_P = 4 * 32;
    constexpr int NITEMS = SET == 0 ? I_A1 + I_A2 : SET == 1 ? I_MI + I_UQ + I_UKV + I_O : I_A1 + I_A2 + I_O + I_P;
    for (int it = gw; it < NITEMS; it += NGW) {
        int r = it;
        if constexpr (SET == 0) {
            if (r < I_A1) { conv_item(L.a1, 1024, 5632, W + OW_A1, 1, scr, r, 176, c.lane); continue; } r -= I_A1;
            conv_item(L.a2, 2816, 1024, W + OW_A2, 0, scr, r, 32, c.lane);
        } else if constexpr (SET == 1) {
            if (r < I_MI) { conv_item(L.mi, 1024, NIN, W + OW_MI, 0, scr, r, 104, c.lane); continue; } r -= I_MI;
            if (r < I_UQ) { conv_item(L.uq, 256, 384, W + OW_UQ, 0, scr, r, 12, c.lane); continue; } r -= I_UQ;
            if (r < I_UKV) { conv_item(L.ukv, 128, 512, W + OW_UKV, 0, scr, r, 16, c.lane); continue; } r -= I_UKV;
            conv_item(L.wo, 1024, 1024, W + OW_O, 0, scr, r, 32, c.lane);
        } else {
            if (r < I_A1) { conv_item(L.b1, 1024, 5632, W + OW_B1, 1, scr, r, 176, c.lane); continue; } r -= I_A1;
            if (r < I_A2) { conv_item(L.b2, 2816, 1024, W + OW_B2, 0, scr, r, 32, c.lane); continue; } r -= I_A2;
            if (r < I_O) { conv_item(L.gt, 1024, 1024, W + OW_GT, 0, scr, r, 32, c.lane); continue; } r -= I_O;
            conv_item(L.pp, 256, 1024, W + OW_P, 0, scr, r, 32, c.lane);
        }
    }
}

DI void ln_phase(const Ctx& c, float* H, bf16_t* HB, const float* g, const float* b) {
    const int gw = c.bid * 8 + c.wid, NGW = c.G * 8;
    for (int m = 2 * gw; m < T_; m += 2 * NGW) {
        f32x4* xr0 = (f32x4*)(H + (size_t)m * DM) + c.lane; f32x4* xr1 = xr0 + DM / 4;
        f32x4 v0[4], v1[4]; float s0 = 0.f, q0 = 0.f, s1 = 0.f, q1 = 0.f;
#pragma unroll
        for (int j = 0; j < 4; ++j) { v0[j] = xr0[64 * j]; v1[j] = xr1[64 * j]; }
#pragma unroll
        for (int j = 0; j < 4; ++j) { s0 += (v0[j][0] + v0[j][1]) + (v0[j][2] + v0[j][3]); q0 += (v0[j][0] * v0[j][0] + v0[j][1] * v0[j][1]) + (v0[j][2] * v0[j][2] + v0[j][3] * v0[j][3]);
            s1 += (v1[j][0] + v1[j][1]) + (v1[j][2] + v1[j][3]); q1 += (v1[j][0] * v1[j][0] + v1[j][1] * v1[j][1]) + (v1[j][2] * v1[j][2] + v1[j][3] * v1[j][3]); }
#pragma unroll
        for (int o = 1; o < 64; o <<= 1) { s0 += __shfl_xor(s0, o); q0 += __shfl_xor(q0, o); s1 += __shfl_xor(s1, o); q1 += __shfl_xor(q1, o); }
        const float mean0 = s0 * (1.f / DM), mean1 = s1 * (1.f / DM);
        const float rstd0 = __builtin_amdgcn_rsqf(fmaxf(q0 * (1.f / DM) - mean0 * mean0, 0.f) + LN_EPS), rstd1 = __builtin_amdgcn_rsqf(fmaxf(q1 * (1.f / DM) - mean1 * mean1, 0.f) + LN_EPS);
        u32x2* o80 = (u32x2*)(HB + (size_t)m * DM) + c.lane; u32x2* o81 = o80 + DM / 4;
#pragma unroll
        for (int j = 0; j < 4; ++j) { const f32x4 gg = ((const f32x4*)g)[c.lane + 64 * j], bb = ((const f32x4*)b)[c.lane + 64 * j];
            const f32x4 a0 = (v0[j] - mean0) * rstd0 * gg + bb, a1 = (v1[j] - mean1) * rstd1 * gg + bb; xr0[64 * j] = a0; xr1[64 * j] = a1;
            u32x2 w0; w0.x = pk2(a0[0], a0[1]); w0.y = pk2(a0[2], a0[3]); o80[64 * j] = w0; u32x2 w1; w1.x = pk2(a1[0], a1[1]); w1.y = pk2(a1[2], a1[3]); o81[64 * j] = w1; }
    }
}
DI void cvt_phase(const Ctx& c, const float* src, bf16_t* dst, float* copy, size_t n) {
    const size_t n4 = n / 4, stride = (size_t)c.G * 512;
    for (size_t i = (size_t)c.bid * 512 + c.tid; i < n4; i += stride) { const f32x4 v = ((const f32x4*)src)[i]; u32x2 w; w.x = pk2(v[0], v[1]); w.y = pk2(v[2], v[3]); ((u32x2*)dst)[i] = w; if (copy) ((f32x4*)copy)[i] = v; }
}
DI void rope_phase(const Ctx& c, const int* pos, f32x2* RT) {
    for (int i = c.bid * 512 + c.tid; i < T_ * 16; i += c.G * 512) {
        const int t = i >> 4, f = i & 15;
        const float e = (float)(2 * f) / 32.0f;
        const float pw = (float)exp2((double)e * 13.287712379549449);
        const float inv = 1.0f / pw;
        const float ang = (float)pos[t] * inv;
        const double rev = (double)ang * 0.15915494309189535; const float fr = (float)(rev - floor(rev));
        RT[i] = (f32x2){__builtin_amdgcn_cosf(fr), __builtin_amdgcn_sinf(fr)};
    }
}

DI void gdn_prefetch(const Ctx& c, int item, const bf16_t* proj, u32x4 (&x)[12], bf16_t& ga, bf16_t& gb) {
    const int tid = c.tid; const int b = item >> 9, h = (item >> 6) & 7, n = item & 63; const int t = tid >> 3, cg8 = tid & 7;
#pragma unroll
    for (int which = 0; which < 3; ++which)
#pragma unroll
        for (int j = 0; j < 4; ++j) { const int sp = n * 64 + t - 3 + j; const int spc = sp >= 0 ? sp : 0;
            x[which * 4 + j] = *(const u32x4*)(proj + (size_t)(b * SEQ + spc) * NINP + which * 512 + h * 64 + cg8 * 8); }
    const size_t ro = (size_t)(b * SEQ + n * 64 + (tid & 63)) * NINP; ga = proj[ro + C_GA + h]; gb = proj[ro + C_GB + h];
}
DI void gdn_prep_item(const Ctx& c, int item, int next_item, u32x4 (&xin)[12], bf16_t& gain, bf16_t& gbin, const bf16_t* proj, const float* conv_w, const float* a_log, const float* dt_bias, unsigned char* gbase, float* GL, const int stop = 0) {
    const int tid = c.tid, lane = c.lane, wid = c.wid;
    const int b = item >> 9, h = (item >> 6) & 7, n = item & 63;
    const int tok0 = b * SEQ + n * 64;
    LAS float* qc = (LAS float*)c.lds; LAS float* kc = qc + 64 * 68; LAS float* vc = kc + 64 * 68; LAS float* Lm = vc + 64 * 68; LAS float* rhs = Lm + 64 * 68; LAS float* gcs = rhs + 64 * 132; LAS float* bet = gcs + 64;
    LAS bf16_t* KH = (LAS bf16_t*)(bet + 64); LAS bf16_t* KL = KH + 64 * 72; LAS bf16_t* QH = KL + 64 * 72; LAS bf16_t* QL = QH + 64 * 72;
    unsigned char* gout = gbase + (size_t)item * GSLOT;
#pragma unroll
    for (int which = 0; which < 3; ++which) {
        const int t = tid >> 3, cg8 = tid & 7; const int col = which * 512 + h * 64 + cg8 * 8;
        float acc[8];
#pragma unroll
        for (int e = 0; e < 8; ++e) acc[e] = 0.f;
#pragma unroll
        for (int j = 0; j < 4; ++j) { const int sp = n * 64 + t - 3 + j; const float ok = sp >= 0 ? 1.f : 0.f;
            const u32x4 xv = xin[which * 4 + j];
            const f32x4 w0 = *(const f32x4*)(conv_w + j * 1536 + col) * ok, w1 = *(const f32x4*)(conv_w + j * 1536 + col + 4) * ok;
            acc[0] += w0[0] * bflo(xv.x); acc[1] += w0[1] * bfhi(xv.x); acc[2] += w0[2] * bflo(xv.y); acc[3] += w0[3] * bfhi(xv.y);
            acc[4] += w1[0] * bflo(xv.z); acc[5] += w1[1] * bfhi(xv.z); acc[6] += w1[2] * bflo(xv.w); acc[7] += w1[3] * bfhi(xv.w); }
#pragma unroll
        for (int e = 0; e < 8; ++e) acc[e] = silu_f(acc[e]);
        if (which == 2) { LAS float* dst = vc + t * 68 + cg8 * 8; *(LAS f32x4*)dst = (f32x4){acc[0], acc[1], acc[2], acc[3]}; *(LAS f32x4*)(dst + 4) = (f32x4){acc[4], acc[5], acc[6], acc[7]}; }
        else {
            float ss = (acc[0] * acc[0] + acc[1] * acc[1]) + (acc[2] * acc[2] + acc[3] * acc[3]) + (acc[4] * acc[4] + acc[5] * acc[5]) + (acc[6] * acc[6] + acc[7] * acc[7]);
            ss += __shfl_xor(ss, 1); ss += __shfl_xor(ss, 2); ss += __shfl_xor(ss, 4);
            const float sc = (which ? 1.0f : 0.125f) * __builtin_amdgcn_rsqf(ss + 1e-6f);
            const f32x4 y0 = (f32x4){acc[0], acc[1], acc[2], acc[3]} * sc, y1 = (f32x4){acc[4], acc[5], acc[6], acc[7]} * sc;
            LAS float* dst = (which ? kc : qc) + t * 68 + cg8 * 8; *(LAS f32x4*)dst = y0; *(LAS f32x4*)(dst + 4) = y1;
            u32x4 hh; hh.x = pk2(y0[0], y0[1]); hh.y = pk2(y0[2], y0[3]); hh.z = pk2(y1[0], y1[1]); hh.w = pk2(y1[2], y1[3]);
            u32x4 lo; lo.x = pk2(y0[0] - bflo(hh.x), y0[1] - bfhi(hh.x)); lo.y = pk2(y0[2] - bflo(hh.y), y0[3] - bfhi(hh.y)); lo.z = pk2(y1[0] - bflo(hh.z), y1[1] - bfhi(hh.z)); lo.w = pk2(y1[2] - bflo(hh.w), y1[3] - bfhi(hh.w));
            *(LAS u32x4*)((which ? KH : QH) + t * 72 + cg8 * 8) = hh; *(LAS u32x4*)((which ? KL : QL) + t * 72 + cg8 * 8) = lo; }
    }
    { const float ga = bf2f(gain), gb = bf2f(gbin);
        const float x = ga + dt_bias[h]; const float sp = fmaxf(x, 0.f) + log1pf(expf(-fabsf(x)));
        float gv = -expf(a_log[h]) * sp; const float bv = 1.f / (1.f + expf(-gb));
        if (wid == 0) {
#pragma unroll
            for (int o = 1; o < 64; o <<= 1) { const float tt = __shfl_up(gv, o); if (lane >= o) gv += tt; }
            gcs[lane] = gv; bet[lane] = bv; } }
    LBAR();
    if (stop == 3) return;
    LAS float* DIV = (LAS float*)(c.lds + 140800);
    const float glog = gcs[63];
    gdn_prefetch(c, next_item, proj, xin, gain, gbin);
    { const int l31 = lane & 31, hi = lane >> 5; const int isqk = wid >> 2, jt = (wid >> 1) & 1, it = wid & 1;
        if (jt <= it) {
            const LAS bf16_t* BH = isqk ? QH : KH; const LAS bf16_t* BL = isqk ? QL : KL;
            bf16x8 aH[4], aLo[4], bH[4], bLo[4];
#pragma unroll
            for (int ks = 0; ks < 4; ++ks) { const int ao = (32 * jt + l31) * 72 + 16 * ks + 8 * hi, bo = (32 * it + l31) * 72 + 16 * ks + 8 * hi;
                aH[ks] = *(const LAS bf16x8*)(KH + ao); aLo[ks] = *(const LAS bf16x8*)(KL + ao); bH[ks] = *(const LAS bf16x8*)(BH + bo); bLo[ks] = *(const LAS bf16x8*)(BL + bo); }
            __builtin_amdgcn_sched_barrier(0);
            f32x16 acc;
#pragma unroll
            for (int r = 0; r < 16; ++r) acc[r] = 0.f;
#pragma unroll
            for (int ks = 0; ks < 4; ++ks) { acc = MFMA32(aH[ks], bH[ks], acc); acc = MFMA32(aH[ks], bLo[ks], acc); acc = MFMA32(aLo[ks], bH[ks], acc); }
            const int i = 32 * it + l31; const float gi = gcs[i], bi = bet[i];
#pragma unroll
            for (int r = 0; r < 16; ++r) { const int j = 32 * jt + crow(r, hi); const float d = fexp2((gi - gcs[j]) * 1.4426950408889634f);
                if (isqk) acc[r] = (j <= i) ? acc[r] * d : 0.f; else Lm[j * 68 + i] = (j < i) ? bi * acc[r] * d : 0.f; }
            if (isqk) {
#pragma unroll
                for (int sx = 0; sx < 2; ++sx) { const bf16x8 pk = pack8(acc, sx); *(u32x4*)(gout + 2 * 8192 + ((it * 4 + 2 * jt + sx) * 64 + lane) * 16) = __builtin_bit_cast(u32x4, pk); } }
            else if (jt == it) {
                const int bb = 2 * jt + ((lane >> 4) & 1), col = lane & 15;
                float y[16];
#pragma unroll
                for (int ii = 0; ii < 16; ++ii) y[ii] = (ii == col) ? 1.f : 0.f;
#pragma unroll
                for (int j = 0; j < 15; ++j) { const float yj = y[j];
#pragma unroll
                    for (int q4 = (j + 1) / 4; q4 < 4; ++q4) { const f32x4 l4 = *(const LAS f32x4*)(Lm + (16 * bb + j) * 68 + 16 * bb + 4 * q4);
#pragma unroll
                        for (int e = 0; e < 4; ++e) if (4 * q4 + e > j) y[4 * q4 + e] -= l4[e] * yj; } }
#pragma unroll
                for (int ii = 0; ii < 16; ++ii) DIV[bb * 320 + ii * 20 + col] = y[ii];
            }
        } else if (isqk) {
#pragma unroll
            for (int sx = 0; sx < 2; ++sx) *(u32x4*)(gout + 2 * 8192 + ((it * 4 + 2 * jt + sx) * 64 + lane) * 16) = (u32x4){0u, 0u, 0u, 0u};
        }
    }
#pragma unroll 2
    for (int e = tid; e < 8192; e += 512) { const int i = e >> 7, cc = e & 127; const float bi = bet[i];
        rhs[i * 132 + cc] = cc < 64 ? vc[i * 68 + cc] * bi : kc[i * 68 + cc - 64] * bi * fexp2(gcs[i] * 1.4426950408889634f); }
#pragma unroll 1
    for (int q = 0; q < 2; ++q) { const int ch = tid + 512 * q; const int mat = ch < 512 ? 1 : 3, idx = ch & 511;
        const int mt = idx >> 8, ks = (idx >> 6) & 3, ln = idx & 63, i = 32 * mt + (ln & 31), hh = ln >> 5, k0 = 16 * ks + 4 * hh;
        float v[8];
        if (mat == 1) { const float e = fexp2(gcs[i] * 1.4426950408889634f); const f32x4 a = *(const LAS f32x4*)(qc + i * 68 + k0), bq = *(const LAS f32x4*)(qc + i * 68 + k0 + 8);
#pragma unroll
            for (int x = 0; x < 4; ++x) { v[x] = a[x] * e; v[4 + x] = bq[x] * e; } }
        else {
#pragma unroll
            for (int x = 0; x < 8; ++x) { const int cr = k0 + (x & 3) + 8 * (x >> 2); v[x] = kc[cr * 68 + i] * fexp2((glog - gcs[cr]) * 1.4426950408889634f); } }
        u32x4 w; w.x = pk2(v[0], v[1]); w.y = pk2(v[2], v[3]); w.z = pk2(v[4], v[5]); w.w = pk2(v[6], v[7]);
        *(u32x4*)(gout + mat * 8192 + idx * 16) = w; }
    LBAR();
    if (stop == 4) return;
    {
        const int g = lane >> 4, nn = lane & 15, cb = 16 * wid + nn;
#pragma unroll
        for (int blk = 0; blk < 4; ++blk) {
            f32x4 acc;
#pragma unroll
            for (int r = 0; r < 4; ++r) acc[r] = rhs[(16 * blk + 4 * g + r) * 132 + cb];
#pragma unroll
            for (int k4 = 0; k4 < 4 * blk; ++k4) { const float av = -Lm[(4 * k4 + g) * 68 + 16 * blk + nn], bv = rhs[(4 * k4 + g) * 132 + cb];
                acc = __builtin_amdgcn_mfma_f32_16x16x4f32(av, bv, acc, 0, 0, 0); }
#pragma unroll
            for (int r = 0; r < 4; ++r) rhs[(16 * blk + 4 * g + r) * 132 + cb] = acc[r];
            f32x4 xs = (f32x4){0.f, 0.f, 0.f, 0.f};
#pragma unroll
            for (int k4 = 0; k4 < 4; ++k4) { const float av = DIV[blk * 320 + nn * 20 + 4 * k4 + g], bv = rhs[(16 * blk + 4 * k4 + g) * 132 + cb];
                xs = __builtin_amdgcn_mfma_f32_16x16x4f32(av, bv, xs, 0, 0, 0); }
#pragma unroll
            for (int r = 0; r < 4; ++r) rhs[(16 * blk + 4 * g + r) * 132 + cb] = xs[r];
        }
    }
    LBAR();
    if (stop == 5) return;
    {
        const int idx = tid; const int mt = idx >> 8, ks = (idx >> 6) & 3, ln = idx & 63, i = 32 * mt + (ln & 31), hh = ln >> 5, k0 = 16 * ks + 4 * hh;
        const f32x4 a = *(const LAS f32x4*)(rhs + i * 132 + 64 + k0), bq = *(const LAS f32x4*)(rhs + i * 132 + 64 + k0 + 8);
        u32x4 w; w.x = pk2(-a[0], -a[1]); w.y = pk2(-a[2], -a[3]); w.z = pk2(-bq[0], -bq[1]); w.w = pk2(-bq[2], -bq[3]);
        *(u32x4*)(gout + idx * 16) = w;
        const int tile = idx >> 7, ln2 = (idx >> 1) & 63, half = idx & 1, ct = tile >> 1, vt = tile & 1, vcol = 32 * vt + (ln2 & 31), h2 = ln2 >> 5;
        float v[8];
#pragma unroll
        for (int e = 0; e < 8; ++e) { const int r = 8 * half + e; v[e] = rhs[(32 * ct + crow(r, h2)) * 132 + vcol]; }
        u32x4 wu; wu.x = pk2(v[0], v[1]); wu.y = pk2(v[2], v[3]); wu.z = pk2(v[4], v[5]); wu.w = pk2(v[6], v[7]);
        *(u32x4*)(gout + 4 * 8192 + idx * 16) = wu;
        if (tid == 0) GL[item] = expf(glog);
    }
}

DI int pos16(int t) { const int x = t & 15; return (t & ~15) | (8 * ((x >> 2) & 1) + 4 * (x >> 3) + (x & 3)); }
DI void mla_prep_item(const Ctx& c, int item, const bf16_t* proj, const float* qnw, const float* kvnw, const bf16_t* Wuq, const bf16_t* Wukv, const f32x2* RT,
                      bf16_t* MQ, bf16_t* MK, bf16_t* MVT, bf16_t* SVT) {
    const int tid = c.tid, lane = c.lane, wid = c.wid;
    const int tok0 = item * 64, b = item >> 6, s0 = (item & 63) * 64;
    LAS bf16_t* A1 = (LAS bf16_t*)c.lds;
    LAS bf16_t* A2 = (LAS bf16_t*)(c.lds + 33792);
    LAS bf16_t* OUT = (LAS bf16_t*)(c.lds + 51200);
    LAS bf16_t* VT = (LAS bf16_t*)(c.lds + 101376);
    LBAR();
    { const int row = 8 * wid + (lane >> 3), ch = lane & 7; const size_t ro = (size_t)(tok0 + row) * NINP;
        u32x4 xq[4], xk[2];
#pragma unroll
        for (int q = 0; q < 4; ++q) xq[q] = *(const u32x4*)(proj + ro + C_MQ + ch * 32 + q * 8);
#pragma unroll
        for (int q = 0; q < 2; ++q) xk[q] = *(const u32x4*)(proj + ro + C_CKV + ch * 16 + q * 8);
        const unsigned r1 = *(const unsigned*)(proj + ro + C_KR + 2 * ch), r2 = *(const unsigned*)(proj + ro + C_KR + 16 + 2 * ch);
        const f32x4 cs = *(const f32x4*)(RT + (size_t)(tok0 + row) * 16 + 2 * ch);
        float ss = 0.f, sk = 0.f;
#pragma unroll
        for (int q = 0; q < 4; ++q) { ss += bflo(xq[q].x) * bflo(xq[q].x) + bfhi(xq[q].x) * bfhi(xq[q].x) + bflo(xq[q].y) * bflo(xq[q].y) + bfhi(xq[q].y) * bfhi(xq[q].y)
                                          + bflo(xq[q].z) * bflo(xq[q].z) + bfhi(xq[q].z) * bfhi(xq[q].z) + bflo(xq[q].w) * bflo(xq[q].w) + bfhi(xq[q].w) * bfhi(xq[q].w); }
#pragma unroll
        for (int q = 0; q < 2; ++q) { sk += bflo(xk[q].x) * bflo(xk[q].x) + bfhi(xk[q].x) * bfhi(xk[q].x) + bflo(xk[q].y) * bflo(xk[q].y) + bfhi(xk[q].y) * bfhi(xk[q].y)
                                          + bflo(xk[q].z) * bflo(xk[q].z) + bfhi(xk[q].z) * bfhi(xk[q].z) + bflo(xk[q].w) * bflo(xk[q].w) + bfhi(xk[q].w) * bfhi(xk[q].w); }
        ss += __shfl_xor(ss, 1); sk += __shfl_xor(sk, 1); ss += __shfl_xor(ss, 2); sk += __shfl_xor(sk, 2); ss += __shfl_xor(ss, 4); sk += __shfl_xor(sk, 4);
        const float rq = __builtin_amdgcn_rsqf(ss * (1.f / 256.f) + 1e-6f), rk = __builtin_amdgcn_rsqf(sk * (1.f / 128.f) + 1e-6f);
        __builtin_amdgcn_sched_barrier(0);
#pragma unroll
        for (int q = 0; q < 4; ++q) { const f32x4 n0 = *(const f32x4*)(qnw + ch * 32 + q * 8), n1 = *(const f32x4*)(qnw + ch * 32 + q * 8 + 4); u32x4 o;
            o.x = pk2(bflo(xq[q].x) * rq * n0[0], bfhi(xq[q].x) * rq * n0[1]); o.y = pk2(bflo(xq[q].y) * rq * n0[2], bfhi(xq[q].y) * rq * n0[3]);
            o.z = pk2(bflo(xq[q].z) * rq * n1[0], bfhi(xq[q].z) * rq * n1[1]); o.w = pk2(bflo(xq[q].w) * rq * n1[2], bfhi(xq[q].w) * rq * n1[3]);
            *(LAS u32x4*)(A1 + row * 264 + ch * 32 + q * 8) = o; __builtin_amdgcn_sched_barrier(0); }
#pragma unroll
        for (int q = 0; q < 2; ++q) { const f32x4 n0 = *(const f32x4*)(kvnw + ch * 16 + q * 8), n1 = *(const f32x4*)(kvnw + ch * 16 + q * 8 + 4); u32x4 o;
            o.x = pk2(bflo(xk[q].x) * rk * n0[0], bfhi(xk[q].x) * rk * n0[1]); o.y = pk2(bflo(xk[q].y) * rk * n0[2], bfhi(xk[q].y) * rk * n0[3]);
            o.z = pk2(bflo(xk[q].z) * rk * n1[0], bfhi(xk[q].z) * rk * n1[1]); o.w = pk2(bflo(xk[q].w) * rk * n1[2], bfhi(xk[q].w) * rk * n1[3]);
            *(LAS u32x4*)(A2 + row * 136 + ch * 16 + q * 8) = o; __builtin_amdgcn_sched_barrier(0); }
        { const float x1a = bflo(r1), x1b = bfhi(r1), x2a = bflo(r2), x2b = bfhi(r2);
            const unsigned y1 = pk2(x1a * cs[0] - x2a * cs[1], x1b * cs[2] - x2b * cs[3]), y2 = pk2(x2a * cs[0] + x1a * cs[1], x2b * cs[2] + x1b * cs[3]);
#pragma unroll
            for (int hh = 0; hh < 4; ++hh) { *(unsigned*)(MK + (size_t)(tok0 + row) * 384 + hh * 96 + 64 + 2 * ch) = y1; *(unsigned*)(MK + (size_t)(tok0 + row) * 384 + hh * 96 + 80 + 2 * ch) = y2; } }
    }
#pragma unroll
    for (int q = 0; q < 4; ++q) { const int ch = tid + 512 * q, t = ch & 63, c8 = ch >> 6; const u32x4 w = *(const u32x4*)(proj + (size_t)(tok0 + t) * NINP + C_SV + c8 * 8); const int p = pos16(t);
        VT[(c8 * 8 + 0) * 72 + p] = (bf16_t)(w.x & 0xffff); VT[(c8 * 8 + 1) * 72 + p] = (bf16_t)(w.x >> 16); VT[(c8 * 8 + 2) * 72 + p] = (bf16_t)(w.y & 0xffff); VT[(c8 * 8 + 3) * 72 + p] = (bf16_t)(w.y >> 16);
        VT[(c8 * 8 + 4) * 72 + p] = (bf16_t)(w.z & 0xffff); VT[(c8 * 8 + 5) * 72 + p] = (bf16_t)(w.z >> 16); VT[(c8 * 8 + 6) * 72 + p] = (bf16_t)(w.w & 0xffff); VT[(c8 * 8 + 7) * 72 + p] = (bf16_t)(w.w >> 16); }
    LBAR();
#pragma unroll
    for (int q = 0; q < 4; ++q) { const int ch = tid + 512 * q, row = ch >> 3, cc = ch & 7; const u32x4 w = *(const LAS u32x4*)(VT + row * 72 + cc * 8);
        *(u32x4*)(SVT + ((size_t)(b * 4 + (row >> 6)) * 64 + (row & 63)) * SEQ + s0 + cc * 8) = w; }
    {
        f32x4 acc[4][3];
#pragma unroll
        for (int m = 0; m < 4; ++m)
#pragma unroll
            for (int nf = 0; nf < 3; ++nf) acc[m][nf] = (f32x4){0.f, 0.f, 0.f, 0.f};
#pragma unroll 2
        for (int kk = 0; kk < 8; ++kk) { bf16x8 a[4], bb[3];
#pragma unroll
            for (int m = 0; m < 4; ++m) a[m] = *(const LAS bf16x8*)(A1 + (16 * m + (lane & 15)) * 264 + kk * 32 + (lane >> 4) * 8);
#pragma unroll
            for (int nf = 0; nf < 3; ++nf) bb[nf] = *(const bf16x8*)(Wuq + (size_t)(16 * (3 * wid + nf) + (lane & 15)) * 256 + kk * 32 + (lane >> 4) * 8);
#pragma unroll
            for (int m = 0; m < 4; ++m)
#pragma unroll
                for (int nf = 0; nf < 3; ++nf) acc[m][nf] = MFMA16(a[m], bb[nf], acc[m][nf]); }
        const float SC = 0.10206207261596575f * 1.4426950408889634f;
#pragma unroll
        for (int m = 0; m < 4; ++m)
#pragma unroll
            for (int r = 0; r < 4; ++r) { const int t = 16 * m + 4 * (lane >> 4) + r;
                float v0 = acc[m][0][r], v1 = acc[m][1][r], v2 = acc[m][2][r];
                { const f32x2 cs = RT[(tok0 + t) * 16 + (lane & 15)]; const float y1 = v1 * cs[0] - v2 * cs[1], y2 = v2 * cs[0] + v1 * cs[1]; v1 = (wid & 1) ? y1 : v1; v2 = (wid & 1) ? y2 : v2; }
                LAS bf16_t* o = OUT + t * 392 + 48 * wid + (lane & 15);
                o[0] = f2bf(v0 * SC); o[16] = f2bf(v1 * SC); o[32] = f2bf(v2 * SC); }
    }
    LBAR();
#pragma unroll
    for (int q = 0; q < 6; ++q) { const int ch = tid + 512 * q, row = ch / 48, cc = ch % 48; const u32x4 w = *(const LAS u32x4*)(OUT + row * 392 + cc * 8);
        *(u32x4*)(MQ + (size_t)(tok0 + row) * 384 + cc * 8) = w; }
    LBAR();
    {   f32x4 acc[4][4];
#pragma unroll
        for (int m = 0; m < 4; ++m)
#pragma unroll
            for (int nf = 0; nf < 4; ++nf) acc[m][nf] = (f32x4){0.f, 0.f, 0.f, 0.f};
#pragma unroll 2
        for (int kk = 0; kk < 4; ++kk) { bf16x8 a[4], bb[4];
#pragma unroll
            for (int m = 0; m < 4; ++m) a[m] = *(const LAS bf16x8*)(A2 + (16 * m + (lane & 15)) * 136 + kk * 32 + (lane >> 4) * 8);
#pragma unroll
            for (int nf = 0; nf < 4; ++nf) bb[nf] = *(const bf16x8*)(Wukv + (size_t)(64 * wid + 16 * nf + (lane & 15)) * 128 + kk * 32 + (lane >> 4) * 8);
#pragma unroll
            for (int m = 0; m < 4; ++m)
#pragma unroll
                for (int nf = 0; nf < 4; ++nf) acc[m][nf] = MFMA16(a[m], bb[nf], acc[m][nf]); }
        const int hh = wid >> 1;
#pragma unroll
        for (int m = 0; m < 4; ++m)
#pragma unroll
            for (int r = 0; r < 4; ++r) { const int t = 16 * m + 4 * (lane >> 4) + r;
#pragma unroll
                for (int nf = 0; nf < 4; ++nf) { const bf16_t v = f2bf(acc[m][nf][r]);
                    if (wid & 1) VT[(hh * 64 + 16 * nf + (lane & 15)) * 72 + pos16(t)] = v; else OUT[t * 392 + hh * 96 + 16 * nf + (lane & 15)] = v; } }
    }
    LBAR();
#pragma unroll
    for (int q = 0; q < 4; ++q) { const int ch = tid + 512 * q, row = ch >> 5, hh = (ch >> 3) & 3, cc = ch & 7; const u32x4 w = *(const LAS u32x4*)(OUT + row * 392 + hh * 96 + cc * 8);
        *(u32x4*)(MK + (size_t)(tok0 + row) * 384 + hh * 96 + cc * 8) = w; }
#pragma unroll
    for (int q = 0; q < 4; ++q) { const int ch = tid + 512 * q, row = ch >> 3, cc = ch & 7; const u32x4 w = *(const LAS u32x4*)(VT + row * 72 + cc * 8);
        *(u32x4*)(MVT + ((size_t)(b * 4 + (row >> 6)) * 64 + (row & 63)) * SEQ + s0 + cc * 8) = w; }
}


constexpr int OT_OFF = 3 * GSLOT + 512;
DI void gdn_step(const Ctx& c, const int n, const int vt, const LAS unsigned char* lds0, f32x16& S0, f32x16& S1, const float gl, bf16_t* proj, const int b, const int h) {
    const int lane = c.lane, hi = lane >> 5;
    const LAS unsigned char* sl = lds0 + (n % 3) * GSLOT;
    bf16x8 sb[4]; sb[0] = pack8(S0, 0); sb[1] = pack8(S0, 1); sb[2] = pack8(S1, 0); sb[3] = pack8(S1, 1);
    f32x16 vn[2], o[2];
#pragma unroll
    for (int ct = 0; ct < 2; ++ct) { const u32x4 u0 = *(const LAS u32x4*)(sl + 4 * 8192 + ((ct * 2 + vt) * 64 + lane) * 32), u1 = *(const LAS u32x4*)(sl + 4 * 8192 + ((ct * 2 + vt) * 64 + lane) * 32 + 16);
        vn[ct][0] = bflo(u0.x); vn[ct][1] = bfhi(u0.x); vn[ct][2] = bflo(u0.y); vn[ct][3] = bfhi(u0.y); vn[ct][4] = bflo(u0.z); vn[ct][5] = bfhi(u0.z); vn[ct][6] = bflo(u0.w); vn[ct][7] = bfhi(u0.w);
        vn[ct][8] = bflo(u1.x); vn[ct][9] = bfhi(u1.x); vn[ct][10] = bflo(u1.y); vn[ct][11] = bfhi(u1.y); vn[ct][12] = bflo(u1.z); vn[ct][13] = bfhi(u1.z); vn[ct][14] = bflo(u1.w); vn[ct][15] = bfhi(u1.w);
#pragma unroll
        for (int r = 0; r < 16; ++r) o[ct][r] = 0.f; }
#define GFRAG(mat, mt, ks) (*(const LAS bf16x8*)(sl + (mat) * 8192 + (((mt) * 4 + (ks)) * 64 + lane) * 16))
#define GLOAD4(dst, mat, mt) do { _Pragma("unroll") for (int ks_ = 0; ks_ < 4; ++ks_) dst[ks_] = GFRAG(mat, mt, ks_); } while (0)
#define SCHEDB() __builtin_amdgcn_sched_barrier(0)
#define MMA4(acc, fr, bop) do { _Pragma("unroll") for (int ks_ = 0; ks_ < 4; ++ks_) acc = MFMA32(fr[ks_], bop[ks_], acc); } while (0)
#define MMA8(acc0, acc1, f0, f1, bop) do { _Pragma("unroll") for (int ks_ = 0; ks_ < 4; ++ks_) { acc0 = MFMA32(f0[ks_], bop[ks_], acc0); acc1 = MFMA32(f1[ks_], bop[ks_], acc1); } } while (0)
    bf16x8 fa[4], fb[4], fc[4], fd[4];
    GLOAD4(fa, 0, 0); GLOAD4(fb, 0, 1); GLOAD4(fc, 1, 0); GLOAD4(fd, 1, 1); SCHEDB();
    MMA8(vn[0], vn[1], fa, fb, sb); SCHEDB();
    GLOAD4(fa, 3, 0); GLOAD4(fb, 3, 1); SCHEDB();
    MMA8(o[0], o[1], fc, fd, sb); SCHEDB();
    GLOAD4(fc, 2, 0); GLOAD4(fd, 2, 1); SCHEDB();
    bf16x8 vb[4]; vb[0] = pack8(vn[0], 0); vb[1] = pack8(vn[0], 1); vb[2] = pack8(vn[1], 0); vb[3] = pack8(vn[1], 1);
#pragma unroll
    for (int r = 0; r < 16; ++r) { S0[r] *= gl; S1[r] *= gl; }
    SCHEDB();
    MMA8(S0, S1, fa, fb, vb);
    MMA8(o[0], o[1], fc, fd, vb);
#undef MMA8
#undef GLOAD4
#undef SCHEDB
#undef MMA4
#undef GFRAG
    LAS bf16_t* ot = (LAS bf16_t*)(lds0 + OT_OFF + (n & 1) * 9216) + crow(0, hi) * 72 + 32 * vt + (lane & 31);
#pragma unroll
    for (int ct = 0; ct < 2; ++ct)
#pragma unroll
        for (int r = 0; r < 16; ++r) ot[(32 * ct + (r & 3) + 8 * (r >> 2)) * 72] = f2bf(o[ct][r]);
}

DI void gdn_scan(const Ctx& c, int bh, const unsigned char* gbase, const float* GL, bf16_t* proj, const float* normw) {
    const int tid = c.tid, lane = c.lane, wid = c.wid, hi = lane >> 5;
    const int b = bh >> 3, h = bh & 7;
    const unsigned char* src = gbase + (size_t)bh * 64 * GSLOT;
    __syncthreads();
#pragma unroll
    for (int q = 0; q < 5; ++q) { *(LAS u32x4*)(c.lds + tid * 16 + q * 8192) = *(const u32x4*)(src + tid * 16 + q * 8192);
        *(LAS u32x4*)(c.lds + GSLOT + tid * 16 + q * 8192) = *(const u32x4*)(src + GSLOT + tid * 16 + q * 8192); }
    f32x16 S0, S1;
#pragma unroll
    for (int r = 0; r < 16; ++r) { S0[r] = 0.f; S1[r] = 0.f; }
    LAS float* glds = (LAS float*)(c.lds + 3 * GSLOT);
    if (tid < 64) glds[tid] = GL[bh * 64 + tid];
    LAS float* nwl = glds + 64; if (tid < 64) nwl[tid] = normw[tid];
    const int lw = wid - 2;
#define GDMA(chunk) do { if ((chunk) < 64) { const unsigned char* g_ = src + (size_t)(chunk) * GSLOT + (size_t)(lw * 64 + lane) * 16; LAS unsigned char* d_ = c.lds + ((chunk) % 3) * GSLOT + lw * 1024; \
        _Pragma("unroll") for (int p = 0; p < 10; ++p) __builtin_amdgcn_global_load_lds((const unsigned*)(g_ + p * 4096), (LAS unsigned*)(d_ + p * 4096), 16, 0, 0); } } while (0)
#define GHELP(chunk, ZR) do { const LAS unsigned char* tp_ = c.lds + OT_OFF + ((chunk) & 1) * 9216 + lane * 144; u32x4 ov_[8]; \
        _Pragma("unroll") for (int k = 0; k < 8; ++k) ov_[k] = *(const LAS u32x4*)(tp_ + k * 16); \
        float ss_ = 0.f; \
        _Pragma("unroll") for (int k = 0; k < 8; ++k) { ss_ += bflo(ov_[k].x) * bflo(ov_[k].x) + bfhi(ov_[k].x) * bfhi(ov_[k].x) + bflo(ov_[k].y) * bflo(ov_[k].y) + bfhi(ov_[k].y) * bfhi(ov_[k].y) \
            + bflo(ov_[k].z) * bflo(ov_[k].z) + bfhi(ov_[k].z) * bfhi(ov_[k].z) + bflo(ov_[k].w) * bflo(ov_[k].w) + bfhi(ov_[k].w) * bfhi(ov_[k].w); } \
        const float rs_ = __builtin_amdgcn_rsqf(ss_ * (1.f / 64.f) + 1e-6f); \
        bf16_t* op_ = proj + (size_t)(b * SEQ + (chunk) * 64 + lane) * NINP + h * 64 + 32 * hc; \
        _Pragma("unroll") for (int k = 0; k < 4; ++k) { const f32x4 n0_ = *(const LAS f32x4*)(nwl + 32 * hc + 8 * k) * rs_, n1_ = *(const LAS f32x4*)(nwl + 32 * hc + 8 * k + 4) * rs_; const u32x4 zv_ = ZR[k]; \
            const u32x4 oq_ = hc ? ov_[4 + k] : ov_[k]; u32x4 w_; \
            w_.x = pk2(bflo(oq_.x) * n0_[0] * silu_f(bflo(zv_.x)), bfhi(oq_.x) * n0_[1] * silu_f(bfhi(zv_.x))); w_.y = pk2(bflo(oq_.y) * n0_[2] * silu_f(bflo(zv_.y)), bfhi(oq_.y) * n0_[3] * silu_f(bfhi(zv_.y))); \
            w_.z = pk2(bflo(oq_.z) * n1_[0] * silu_f(bflo(zv_.z)), bfhi(oq_.z) * n1_[1] * silu_f(bfhi(zv_.z))); w_.w = pk2(bflo(oq_.w) * n1_[2] * silu_f(bflo(zv_.w)), bfhi(oq_.w) * n1_[3] * silu_f(bfhi(zv_.w))); \
            *(u32x4*)(op_ + 8 * k) = w_; } } while (0)
#define GZLOAD(ZR, chunk) do { const bf16_t* zp_ = proj + (size_t)(b * SEQ + (chunk) * 64 + lane) * NINP + C_GZ + h * 64 + 32 * hc; \
        _Pragma("unroll") for (int k = 0; k < 4; ++k) ZR[k] = *(const u32x4*)(zp_ + 8 * k); } while (0)
    if (wid >= 6) {
        const int hc = wid - 6;
        u32x4 zA[4], zB[4];
        GZLOAD(zA, 0);
        for (int n = 0; n < 64; n += 2) {
            LBAR(); if (n > 0) GHELP(n - 1, zB); GZLOAD(zB, n + 1);
            LBAR(); GHELP(n, zA); { const int nx = n + 2 < 64 ? n + 2 : 63; GZLOAD(zA, nx); }
        }
        LBAR();
        GHELP(63, zB);
    } else {
        if (wid >= 2) GDMA(2);
        const LAS unsigned char* sl_base = c.lds;
        for (int n = 0; n < 64; ++n) {
            if (wid >= 2) { if (n + 2 < 64 && n > 0) asm volatile("s_waitcnt vmcnt(10)" ::: "memory"); else asm volatile("s_waitcnt vmcnt(0)" ::: "memory"); }
            LBAR();
            if (wid >= 2) { if (n > 0) GDMA(n + 2); }
            else gdn_step(c, n, wid, sl_base, S0, S1, glds[n], proj, b, h);
        }
        LBAR();
    }
#undef GDMA
#undef GHELP
#undef GZLOAD
}

template <int MODE>
DI void attn_unit(const Ctx& c, int bh, int qb, const bf16_t* Qp, int qpitch, const bf16_t* Kp, int kpitch, const bf16_t* VTp, bf16_t* Op, int opitch) {
    constexpr int DQK = MODE ? 96 : 64, NKS = DQK / 16, KSTR = (DQK + 8) * 2, CPR = DQK / 8, KBYTES = 64 * KSTR;
    const int tid = c.tid, lane = c.lane, wid = c.wid, l31 = lane & 31, hi = lane >> 5;
    const int b = bh >> 2, hh = bh & 3; const size_t rowbase = (size_t)b * SEQ;
    const int q0 = qb * 256, qw0 = q0 + 32 * wid, NT = 4 * qb + 4;
    LAS unsigned char* KB = c.lds; LAS unsigned char* VB = c.lds + 2 * KBYTES; LAS bf16_t* OST = (LAS bf16_t*)(c.lds + 2 * KBYTES + 2 * 9216 + wid * 4608);
    const bf16_t* Kh = Kp + rowbase * kpitch + hh * DQK; const bf16_t* Vh = VTp + (size_t)(b * 4 + hh) * 64 * SEQ;
    bf16x8 qf[NKS];
#pragma unroll
    for (int ks = 0; ks < NKS; ++ks) qf[ks] = *(const bf16x8*)(Qp + (rowbase + qw0 + l31) * qpitch + hh * DQK + 16 * ks + 8 * hi);
    f32x16 o[2];
#pragma unroll
    for (int r = 0; r < 16; ++r) { o[0][r] = 0.f; o[1][r] = 0.f; }
    float mrun = -1e30f, lrun = 0.f, R = 0.f;
    bf16x8 uf[2];
    if (MODE == 0) {
#pragma unroll
        for (int s = 0; s < 2; ++s)
#pragma unroll
            for (int j = 0; j < 8; ++j) { const int k = 16 * s + 8 * (j >> 2) + 4 * hi + (j & 3); uf[s][j] = (k >= l31) ? (short)0x3F80 : (short)0; } }
    u32x4 pk_[2], pv_;
    const int krow0 = tid / CPR, kcc0 = tid % CPR, krow1 = ((tid & 255) + 512) / CPR, kcc1 = ((tid & 255) + 512) % CPR;
#define PREFETCH(t) do { const size_t kr_ = (size_t)64 * (t); pk_[0] = *(const u32x4*)(Kh + (kr_ + krow0) * kpitch + kcc0 * 8); \
        if (MODE == 1) pk_[1] = *(const u32x4*)(Kh + (kr_ + krow1) * kpitch + kcc1 * 8); \
        pv_ = *(const u32x4*)(Vh + (size_t)(tid >> 3) * SEQ + kr_ + (tid & 7) * 8); } while (0)
    int done = 0;
    PREFETCH(MODE ? 0 : NT - 1);
    for (int it = 0; it < NT; ++it) {
        const int t = MODE ? it : NT - 1 - it;
        LAS unsigned char* kb = KB + (it & 1) * KBYTES; LAS unsigned char* vbuf = VB + (it & 1) * 9216;
        *(LAS u32x4*)(kb + krow0 * KSTR + kcc0 * 16) = pk_[0];
        if (MODE == 1 && tid < 256) *(LAS u32x4*)(kb + krow1 * KSTR + kcc1 * 16) = pk_[1];
        *(LAS u32x4*)(vbuf + (tid >> 3) * 144 + (tid & 7) * 16) = pv_;
        if (MODE == 0) { if (__syncthreads_and(done)) break; } else __syncthreads();
        if (it + 1 < NT) PREFETCH(MODE ? it + 1 : NT - 2 - it);
#define KFRAG(sub, ks) (*(const LAS bf16x8*)(kb + (32 * (sub) + l31) * KSTR + (16 * (ks) + 8 * hi) * 2))
#define VFRAG(dt, sub, s2) (*(const LAS bf16x8*)(vbuf + (32 * (dt) + l31) * 144 + (32 * (sub) + 16 * (s2) + 8 * hi) * 2))
        if (MODE == 1) {
            if (64 * t <= qw0 + 31) {
                f32x16 s0, s1;
#pragma unroll
                for (int r = 0; r < 16; ++r) { s0[r] = 0.f; s1[r] = 0.f; }
                bf16x8 kf0[NKS], kf1[NKS], vf[8];
#pragma unroll
                for (int ks = 0; ks < NKS; ++ks) { kf0[ks] = KFRAG(0, ks); kf1[ks] = KFRAG(1, ks); }
                __builtin_amdgcn_sched_barrier(0);
#pragma unroll
                for (int ks = 0; ks < NKS; ++ks) { s0 = MFMA32(kf0[ks], qf[ks], s0); s1 = MFMA32(kf1[ks], qf[ks], s1); }
                __builtin_amdgcn_sched_barrier(0);
#pragma unroll
                for (int dt = 0; dt < 2; ++dt) { vf[dt * 4 + 0] = VFRAG(dt, 0, 0); vf[dt * 4 + 1] = VFRAG(dt, 0, 1); vf[dt * 4 + 2] = VFRAG(dt, 1, 0); vf[dt * 4 + 3] = VFRAG(dt, 1, 1); }
                __builtin_amdgcn_sched_barrier(0);
                if (64 * t + 63 > qw0) { const int q = qw0 + l31;
#pragma unroll
                    for (int r = 0; r < 16; ++r) { const int key = 64 * t + crow(r, hi); if (key > q) s0[r] = -INFINITY; if (key + 32 > q) s1[r] = -INFINITY; } }
                float mx = fmaxf(s0[0], s1[0]);
#pragma unroll
                for (int r = 1; r < 16; ++r) mx = fmaxf(mx, fmaxf(s0[r], s1[r]));
                mx = half_max(mx);
                const float mn = fmaxf(mrun, mx), al = fexp2(mrun - mn); mrun = mn;
                float ls = 0.f;
#pragma unroll
                for (int r = 0; r < 16; ++r) { s0[r] = fexp2(s0[r] - mn); s1[r] = fexp2(s1[r] - mn); ls += s0[r] + s1[r]; }
                lrun = lrun * al + ls;
#pragma unroll
                for (int r = 0; r < 16; ++r) { o[0][r] *= al; o[1][r] *= al; }
                const bf16x8 p0 = pack8(s0, 0), p1 = pack8(s0, 1), p2 = pack8(s1, 0), p3 = pack8(s1, 1);
#pragma unroll
                for (int dt = 0; dt < 1; ++dt) { o[0] = MFMA32(vf[0], p0, o[0]); o[1] = MFMA32(vf[4], p0, o[1]); o[0] = MFMA32(vf[1], p1, o[0]); o[1] = MFMA32(vf[5], p1, o[1]);
                    o[0] = MFMA32(vf[2], p2, o[0]); o[1] = MFMA32(vf[6], p2, o[1]); o[0] = MFMA32(vf[3], p3, o[0]); o[1] = MFMA32(vf[7], p3, o[1]); }
            }
        } else {
            const float C2 = 0.125f * 1.4426950408889634f;
#pragma unroll
            for (int sub = 1; sub >= 0; --sub) {
                const int kbase = 64 * t + 32 * sub;
                if (kbase < qw0 + 31) {
                    f32x16 s;
#pragma unroll
                    for (int r = 0; r < 16; ++r) s[r] = 0.f;
                    bf16x8 kfs[NKS], vfs[4];
#pragma unroll
                    for (int ks = 0; ks < NKS; ++ks) kfs[ks] = KFRAG(sub, ks);
                    __builtin_amdgcn_sched_barrier(0);
#pragma unroll
                    for (int ks = 0; ks < NKS; ++ks) s = MFMA32(kfs[ks], qf[ks], s);
                    __builtin_amdgcn_sched_barrier(0);
                    vfs[0] = VFRAG(0, sub, 0); vfs[1] = VFRAG(0, sub, 1); vfs[2] = VFRAG(1, sub, 0); vfs[3] = VFRAG(1, sub, 1);
                    __builtin_amdgcn_sched_barrier(0);
                    const bool need_mask = (kbase + 31 >= qw0); const int q = qw0 + l31;
                    f32x16 lm, rin; float rsum = 0.f;
#pragma unroll
                    for (int r = 0; r < 16; ++r) { const float z2 = s[r] * C2; const float e = fexp2(-fabsf(z2)); float v = -(fmaxf(z2, 0.f) + flog2(1.f + e));
                        const bool valid = !need_mask || (kbase + crow(r, hi) < q);
                        v = valid ? v : 0.f; lm[r] = v; s[r] = valid ? z2 : -INFINITY; rsum += v; rin[r] = R; }
                    f32x16 lo;
                    const bf16x8 h0 = pack8(lm, 0), h1 = pack8(lm, 1);
#pragma unroll
                    for (int r = 0; r < 8; ++r) { lo[r] = lm[r] - __uint_as_float(((unsigned)(unsigned short)h0[r]) << 16); lo[8 + r] = lm[8 + r] - __uint_as_float(((unsigned)(unsigned short)h1[r]) << 16); }
                    const bf16x8 l0 = pack8(lo, 0), l1 = pack8(lo, 1);
                    f32x16 cum = MFMA32(uf[0], h0, rin); cum = MFMA32(uf[1], h1, cum); cum = MFMA32(uf[0], l0, cum); cum = MFMA32(uf[1], l1, cum);
                    rsum = half_sum(rsum); R += rsum;
#pragma unroll
                    for (int r = 0; r < 16; ++r) s[r] = fexp2(s[r] + cum[r]);
                    const bf16x8 p0 = pack8(s, 0), p1 = pack8(s, 1);
#pragma unroll
                    for (int dt = 0; dt < 1; ++dt) { o[0] = MFMA32(vfs[0], p0, o[0]); o[1] = MFMA32(vfs[2], p0, o[1]); o[0] = MFMA32(vfs[1], p1, o[0]); o[1] = MFMA32(vfs[3], p1, o[1]); }
                }
            }
            done = __all(R < -152.0f) ? 1 : 0;
        }
#undef KFRAG
#undef VFRAG
    }
#undef PREFETCH
    float inv = 1.f;
    if (MODE == 1) { lrun = half_sum(lrun); inv = 1.f / lrun; }
#pragma unroll
    for (int dt = 0; dt < 2; ++dt)
#pragma unroll
        for (int r = 0; r < 16; ++r) OST[l31 * 72 + 32 * dt + crow(r, hi)] = f2bf(o[dt][r] * inv);
    asm volatile("s_waitcnt lgkmcnt(0)" ::: "memory");
#pragma unroll
    for (int i = 0; i < 4; ++i) { const int row = i * 8 + (lane >> 3), ch = lane & 7; const u32x4 v = *(const LAS u32x4*)(OST + row * 72 + ch * 8);
        *(u32x4*)(Op + (rowbase + qw0 + row) * opitch + hh * 64 + ch * 8) = v; }
    __syncthreads();
}


#define XB_TMO      128
#define XB_XCNT(j)  (256  + 64 * (j))
#define XB_XSUB(j)  (1280 + 64 * (j))
#define XB_XGEN(j)  (2304 + 64 * (j))
#define XB_TOP      3328
#define XB_TOPGEN   3392
#define XB_SPIN_CAP (1u << 22)
DI unsigned xb_ld(unsigned* p)              { return __hip_atomic_load(p, __ATOMIC_RELAXED, __HIP_MEMORY_SCOPE_AGENT); }
DI unsigned xb_add(unsigned* p, unsigned v) { return __hip_atomic_fetch_add(p, v, __ATOMIC_RELAXED, __HIP_MEMORY_SCOPE_AGENT); }
DI unsigned xb_xcc_id() { return (unsigned)__builtin_amdgcn_s_getreg((3 << 11) | 20) & 0xFu; }
#define XB_SPIN(cond, bar) do { unsigned _sp = 0; while (cond) { __builtin_amdgcn_s_sleep(1); \
    if ((++_sp & 255u) == 0u) { if (xb_ld(&(bar)[XB_TMO])) break; if (_sp > XB_SPIN_CAP) { atomicAdd(&(bar)[XB_TMO], 1u); break; } } } } while (0)
struct XcdBarrier { unsigned* bar; unsigned x; volatile LAS unsigned* st; };
DI XcdBarrier xcd_barrier_post(unsigned* bar, volatile LAS unsigned* st, bool post) {
    XcdBarrier b; b.bar = bar; b.x = xb_xcc_id(); b.st = st;
    if (post && threadIdx.x == 0) (void)xb_add(&bar[XB_XCNT(b.x)], 1u);
    return b;
}
DI void xcd_barrier_complete(unsigned* bar, unsigned x, unsigned& nloc, unsigned& nx) {
    const unsigned G = gridDim.x * gridDim.y * gridDim.z;
    unsigned sum, cnt, mine, sp = 0u;
    for (;;) {
        sum = 0u; cnt = 0u; mine = 0u;
#pragma unroll
        for (unsigned j = 0; j < 16; ++j) { const unsigned cc = xb_ld(&bar[XB_XCNT(j)]); sum += cc; cnt += (cc > 0u) ? 1u : 0u; mine = (j == x) ? cc : mine; }
        if (sum == G) break;
        __builtin_amdgcn_s_sleep(1);
        if ((++sp & 255u) == 0u) { if (xb_ld(&bar[XB_TMO])) break; if (sp > XB_SPIN_CAP) { atomicAdd(&bar[XB_TMO], 1u); break; } }
    }
    nloc = mine > 0u ? mine : 1u; nx = cnt > 0u ? cnt : 1u;
}
DI void xcd_barrier(const XcdBarrier& b) {
    asm volatile("s_waitcnt vmcnt(0)" ::: "memory");
    __syncthreads();
    if (threadIdx.x == 0) {
        unsigned* bar = b.bar;
        __builtin_amdgcn_s_waitcnt(0);
        unsigned nloc = b.st[0], nx = b.st[1];
        if (nloc == 0u) { xcd_barrier_complete(bar, b.x, nloc, nx); b.st[0] = nloc; b.st[1] = nx; }
        const unsigned old = xb_add(&bar[XB_XSUB(b.x)], 1u);
        const unsigned gen = old / nloc;
        if (old + 1u == (gen + 1u) * nloc) {
            __builtin_amdgcn_fence(__ATOMIC_RELEASE, "agent");
            asm volatile("s_waitcnt vmcnt(0)" ::: "memory");
            const unsigned og = xb_add(&bar[XB_TOP], 1u);
            const unsigned tg = og / nx;
            if (og + 1u == (tg + 1u) * nx) xb_add(&bar[XB_TOPGEN], 1u);
            else XB_SPIN(xb_ld(&bar[XB_TOPGEN]) == tg, bar);
            __builtin_amdgcn_fence(__ATOMIC_ACQUIRE, "agent");
            xb_add(&bar[XB_XGEN(b.x)], 1u);
            asm volatile("s_waitcnt vmcnt(0)" ::: "memory");
        } else {
            XB_SPIN(xb_ld(&bar[XB_XGEN(b.x)]) == gen, bar);
            __builtin_amdgcn_fence(__ATOMIC_ACQUIRE, "agent");
            asm volatile("s_waitcnt vmcnt(0)" ::: "memory");
        }
    }
    __syncthreads();
}

struct Args { const float* in[21]; float* out; unsigned char* ws; int ph_lo, ph_hi, rep, pad; };
constexpr int NPHASE = 27;

template <int SP> DI void do_phase(const Ctx& c, const Args& args, const int l, const int rep = 0) {
    unsigned char* ws = args.ws;
    bf16_t* W = (bf16_t*)(ws + WS_W); bf16_t* AB = (bf16_t*)(ws + WS_AB); bf16_t* HB0 = (bf16_t*)(ws + WS_G); bf16_t* HB1 = (bf16_t*)(ws + WS_HB1);
    float* H = args.out;
    const float* ln_g = args.in[17] + (size_t)l * 3 * DM; const float* ln_b = args.in[18] + (size_t)l * 3 * DM;
    LayerW L; L.a1 = args.in[3] + (size_t)l * 1024 * 5632; L.a2 = args.in[4] + (size_t)l * 2816 * 1024; L.mi = args.in[5] + (size_t)l * 1024 * NIN; L.uq = args.in[12] + (size_t)l * 256 * 384;
    L.ukv = args.in[13] + (size_t)l * 128 * 512; L.wo = args.in[14] + (size_t)l * 1024 * 1024; L.b1 = args.in[15] + (size_t)l * 1024 * 5632; L.b2 = args.in[16] + (size_t)l * 2816 * 1024;
    L.gt = args.in[19] + (size_t)l * 1024 * 1024; L.pp = args.in[20] + (size_t)l * 256 * 1024;
    if constexpr (SP == 0) {
        if (l == 0) { cvt_phase(c, args.in[0], HB0, nullptr, (size_t)T_ * DM); rope_phase(c, (const int*)args.in[2], (f32x2*)(ws + WS_ROPE)); }
        conv_phase<0>(c, L, W, c.bid * 8 + c.wid, c.G * 8); }
    else if constexpr (SP == 1 || SP == 9) { pg8::Gemm g{SP == 1 ? (l == 0 ? HB0 : HB1) : HB0, W + (SP == 1 ? OW_A1 : OW_B1), T_, 5632, 1024, 1024}; pg8::StaticOrder S; S.init(T_, 5632, c.G, c.bid);
        pg8::EpiSwiGLU E{AB, DFF}; pg8::gemm_phase<pg8::EpiSwiGLU, pg8::StaticOrder, true>(c.lds, g, S, E);
        if (c.G == 256 && c.bid >= 128) {
            if constexpr (SP == 1) conv_phase<1>(c, L, W, (c.bid - 128) * 8 + c.wid, 128 * 8);
            else { pg8::Gemm g2{(const bf16_t*)(ws + WS_SVT), W + OW_P, T_, 1024, 256, 256}; pg8::StaticOrder S2; S2.init(T_, 1024, 128, c.bid - 128);
                pg8::EpiBf16 E2{(bf16_t*)(ws + WS_MQ), DM}; pg8::gemm_phase<pg8::EpiBf16, pg8::StaticOrder, true>(c.lds, g2, S2, E2); }
        } else if (c.G != 256) {
            if constexpr (SP == 1) conv_phase<1>(c, L, W, c.bid * 8 + c.wid, c.G * 8);
            else { pg8::Gemm g2{(const bf16_t*)(ws + WS_SVT), W + OW_P, T_, 1024, 256, 256}; pg8::StaticOrder S2; S2.init(T_, 1024, c.G, c.bid);
                pg8::EpiBf16 E2{(bf16_t*)(ws + WS_MQ), DM}; pg8::gemm_phase<pg8::EpiBf16, pg8::StaticOrder, true>(c.lds, g2, S2, E2); }
        } }
    else if constexpr (SP == 2 || SP == 10) { pg8::Gemm g{AB, W + (SP == 2 ? OW_A2 : OW_B2), T_, 1024, DFF, DFF}; pg8::StaticOrder S; S.init(T_, 1024, c.G, c.bid);
        pg8::EpiResidLn E{(SP == 2 && l == 0) ? args.in[0] : H, H, HB0, DM, ALPHA, 0.5f, ln_g + (SP == 2 ? 0 : 2 * DM), ln_b + (SP == 2 ? 0 : 2 * DM),
                          (unsigned long long*)(ws + WS_CTL + 524288), (unsigned*)(ws + WS_CTL + 131072) + (l * 3 + (SP == 2 ? 0 : 2)) * 4096};
        pg8::gemm_phase<pg8::EpiResidLn, pg8::StaticOrder, false>(c.lds, g, S, E); }
    else if constexpr (SP == 3) ln_phase(c, H, HB0, ln_g, ln_b);
    else if constexpr (SP == 4) { pg8::Gemm g{HB0, W + OW_MI, T_, NINP, 1024, 1024}; pg8::StaticOrder S; S.init(T_, NINP, c.G, c.bid);
        pg8::EpiBf16 E{AB, NINP}; pg8::gemm_phase<pg8::EpiBf16, pg8::StaticOrder, true>(c.lds, g, S, E);
        LayerW Ln; Ln.a1 = args.in[3] + (size_t)1 * 1024 * 5632; Ln.a2 = args.in[4] + (size_t)1 * 2816 * 1024; Ln.mi = Ln.uq = Ln.ukv = Ln.wo = Ln.b1 = Ln.b2 = Ln.gt = Ln.pp = nullptr;
        if (c.G == 256) { if (c.bid >= 64) { conv_phase<2>(c, L, W, (c.bid - 64) * 8 + c.wid, 192 * 8); if (l == 0) conv_phase<0>(c, Ln, W, (c.bid - 64) * 8 + c.wid, 192 * 8); } }
        else { conv_phase<2>(c, L, W, c.bid * 8 + c.wid, c.G * 8); if (l == 0) conv_phase<0>(c, Ln, W, c.bid * 8 + c.wid, c.G * 8); } }
    else if constexpr (SP == 5) {
        float* GL = (float*)(ws + WS_GL); const f32x2* RT = (const f32x2*)(ws + WS_ROPE);
        if (rep != 2) { u32x4 gx[12]; bf16_t gga = 0, ggb = 0;
            if (c.bid < 2048) gdn_prefetch(c, c.bid, AB, gx, gga, ggb);
            for (int it = c.bid; it < 2048; it += c.G) gdn_prep_item(c, it, it + c.G < 2048 ? it + c.G : it, gx, gga, ggb, AB, args.in[6] + (size_t)l * 4 * 1536, args.in[7] + l * 8, args.in[8] + l * 8, ws + WS_G, GL, rep); }
        if (rep != 1) for (int it = c.bid; it < 256; it += c.G) mla_prep_item(c, it, AB, args.in[10] + l * 256, args.in[11] + l * 128, W + OW_UQ, W + OW_UKV, RT, (bf16_t*)(ws + WS_MQ), (bf16_t*)(ws + WS_MK), (bf16_t*)(ws + WS_MVT), (bf16_t*)(ws + WS_SVT));
    }
    else if constexpr (SP == 6) {
        unsigned* ctl = (unsigned*)(ws + WS_CTL); const float* GL = (const float*)(ws + WS_GL);
        LAS unsigned* qword = (LAS unsigned*)(c.lds + 147000);
#ifndef NO_SCAN
        if (rep != 2) for (int g = c.bid; g < 32; g += c.G) gdn_scan(c, g, ws + WS_G, GL, AB, args.in[9] + l * 64);
#endif
#ifndef NO_ATTN
        if (rep != 1) for (;;) {
            __syncthreads();
            if (c.tid == 0) *qword = atomicAdd(ctl + 64 * (1 + l + 2 * rep), 1u);
            __syncthreads();
            const unsigned u = *qword;
            if (u >= 512u) break;
            const int bh = u & 15, qb = 15 - ((u >> 4) & 15);
            if (u < 256u) attn_unit<1>(c, bh, qb, (const bf16_t*)(ws + WS_MQ), 384, (const bf16_t*)(ws + WS_MK), 384, (const bf16_t*)(ws + WS_MVT), AB + 768, NINP);
#ifndef NO_SB
            else attn_unit<0>(c, bh, qb, AB + C_SQ, NINP, AB + C_SK, NINP, (const bf16_t*)(ws + WS_SVT), AB + 512, NINP);
#endif
        }
#endif
    }
    else if constexpr (SP == 7) { pg8::Gemm g{AB, W + OW_O, T_, 1024, 1024, NINP}; pg8::StaticOrder S; S.init(T_, 1024, c.G, c.bid);
        pg8::EpiResidLn E{H, H, HB0, DM, ALPHA, 1.0f, ln_g + DM, ln_b + DM, (unsigned long long*)(ws + WS_CTL + 524288), (unsigned*)(ws + WS_CTL + 131072) + (l * 3 + 1) * 4096};
        pg8::gemm_phase<pg8::EpiResidLn, pg8::StaticOrder, false>(c.lds, g, S, E);
        cvt_phase(c, args.in[1] + (size_t)l * T_ * 256, (bf16_t*)(ws + WS_SVT), nullptr, (size_t)T_ * 256); }
    else if constexpr (SP == 8) { ln_phase(c, H, HB0, ln_g + DM, ln_b + DM); cvt_phase(c, args.in[1] + (size_t)l * T_ * 256, (bf16_t*)(ws + WS_PB), nullptr, (size_t)T_ * 256); }
    else if constexpr (SP == 11) { pg8::Gemm g{(const bf16_t*)(ws + WS_SVT), W + OW_P, T_, 1024, 256, 256}; pg8::StaticOrder S; S.init(T_, 1024, c.G, c.bid);
        pg8::EpiBf16 E{(bf16_t*)(ws + WS_MQ), DM}; pg8::gemm_phase<pg8::EpiBf16, pg8::StaticOrder, true>(c.lds, g, S, E); }
    else if constexpr (SP == 12) { pg8::Gemm g{HB0, W + OW_GT, T_, 1024, 1024, 1024}; pg8::StaticOrder S; S.init(T_, 1024, c.G, c.bid);
        pg8::EpiPle E{H, (const bf16_t*)(ws + WS_MQ), HB1, DM}; pg8::gemm_phase<pg8::EpiPle, pg8::StaticOrder, true>(c.lds, g, S, E); }
}

#ifndef SPMASK
#define SPMASK 0x16f7
#endif
#ifndef PROBE_REP
#define PROBE_REP 1
#endif
#ifndef PROBE_SPMASK
#define PROBE_SPMASK 0
#endif
__global__ void __launch_bounds__(512, 2) mk_fwd(Args args) {
    extern __shared__ __attribute__((aligned(16))) unsigned char lds_raw[];
    Ctx c; c.lds = (LAS unsigned char*)lds_raw; c.tid = threadIdx.x; c.lane = c.tid & 63; c.wid = __builtin_amdgcn_readfirstlane(c.tid >> 6); c.G = gridDim.x; c.bid = blockIdx.x;
    cg::grid_group grid = cg::this_grid();
    const int lo = args.ph_lo, hi = args.ph_hi;
    volatile LAS unsigned* xst = (volatile LAS unsigned*)(c.lds + 147008);
    if (c.tid == 0) { xst[0] = 0u; xst[1] = 0u; }
    __syncthreads();
    const XcdBarrier xbar = xcd_barrier_post((unsigned*)(args.ws + WS_CTL) + 1024, xst, hi - lo > 1);
    if (lo < 0) grid.sync();
#define SEAM(idx) if ((idx) > lo && (idx) > 1) { xcd_barrier(xbar); }
#define PH(L, SP) if (((SPMASK >> SP) & 1) && lo <= 1 + 13 * L + SP && 1 + 13 * L + SP < hi) { SEAM(1 + 13 * L + SP) do_phase<SP>(c, args, L, args.rep); }
    PH(0, 0) PH(0, 1) PH(0, 2) PH(0, 3) PH(0, 4) PH(0, 5) PH(0, 6) PH(0, 7) PH(0, 8) PH(0, 9) PH(0, 10) PH(0, 11) PH(0, 12)
      PH(1, 1) PH(1, 2) PH(1, 3) PH(1, 4) PH(1, 5) PH(1, 6) PH(1, 7) PH(1, 8) PH(1, 9) PH(1, 10) PH(1, 11) PH(1, 12)
#undef PH
#undef SEAM
}

extern "C" void kernel_launch(void* const* d_in, const int* in_sizes, int n_in, void* d_out, int out_size, void* d_ws, size_t ws_size, hipStream_t stream) {
    static int grid = 0;
    if (grid == 0) {
        if (n_in != 21 || out_size != T_ * DM || ws_size < WS_END) { fprintf(stderr, "kernel_launch: unexpected shapes (n_in %d out %d ws %zu)\n", n_in, out_size, ws_size); grid = -1; return; }
        int dev = 0, cus = 0, per_cu = 0;
        hipGetDevice(&dev); hipDeviceGetAttribute(&cus, hipDeviceAttributeMultiprocessorCount, dev);
        if (hipFuncSetAttribute((const void*)mk_fwd, hipFuncAttributeMaxDynamicSharedMemorySize, LDS_BYTES) != hipSuccess) { fprintf(stderr, "kernel_launch: hipFuncSetAttribute failed\n"); grid = -1; return; }
        if (hipOccupancyMaxActiveBlocksPerMultiprocessor(&per_cu, (const void*)mk_fwd, 512, LDS_BYTES) != hipSuccess || per_cu < 1) { fprintf(stderr, "kernel_launch: occupancy query %d\n", per_cu); per_cu = 1; }
        (void)hipGetLastError();
        grid = cus * 1;
    }
    if (grid < 0) return;
    hipMemsetAsync((char*)d_ws + WS_CTL, 0, 262144, stream);
    Args a{};
    for (int i = 0; i < 21; ++i) a.in[i] = (const float*)d_in[i];
    a.out = (float*)d_out; a.ws = (unsigned char*)d_ws;
#if MK_ONE_LAUNCH
    a.ph_lo = 0; a.ph_hi = NPHASE;
    void* kargs[] = {&a};
    hipError_t e = hipLaunchCooperativeKernel((const void*)mk_fwd, dim3(grid), dim3(512), kargs, LDS_BYTES, stream);
    if (e != hipSuccess) fprintf(stderr, "cooperative launch failed: %s (grid %d)\n", hipGetErrorString(e), grid);
#else
    for (int ph = 0; ph < NPHASE; ++ph) { a.ph_lo = ph; a.ph_hi = ph + 1; a.rep = 0; hipLaunchKernelGGL(mk_fwd, dim3(grid), dim3(512), LDS_BYTES, stream, a);
        if (ph >= 1 && ((PROBE_SPMASK >> ((ph - 1) % 13)) & 1)) { a.rep = PROBE_REP; hipLaunchKernelGGL(mk_fwd, dim3(grid), dim3(512), LDS_BYTES, stream, a); } }
#endif
}
```

```cpp
#include <hip/hip_runtime.h>
#include <hip/hip_cooperative_groups.h>
#include <cstdio>
#include <cstdint>
namespace cg = cooperative_groups;

#ifndef MK_ONE_LAUNCH
#define MK_ONE_LAUNCH 1
#endif

#define LAS __attribute__((address_space(3)))
#define DI __device__ __forceinline__
typedef unsigned short bf16_t;
typedef short bf16x8 __attribute__((ext_vector_type(8)));
typedef float f32x4 __attribute__((ext_vector_type(4)));
typedef float f32x2 __attribute__((ext_vector_type(2)));
typedef float f32x16 __attribute__((ext_vector_type(16)));
typedef unsigned u32x4 __attribute__((ext_vector_type(4)));
typedef unsigned u32x2 __attribute__((ext_vector_type(2)));

DI unsigned pk2(float lo, float hi) { typedef __bf16 b2 __attribute__((ext_vector_type(2))); f32x2 v = {lo, hi}; b2 b = __builtin_convertvector(v, b2); return __builtin_bit_cast(unsigned, b); }
DI float bflo(unsigned w) { return __uint_as_float(w << 16); }
DI float bfhi(unsigned w) { return __uint_as_float(w & 0xffff0000u); }
DI float bf2f(bf16_t u) { return __uint_as_float(((unsigned)u) << 16); }
DI bf16_t f2bf(float f) { return (bf16_t)(pk2(f, 0.f) & 0xffffu); }
DI float wave_sum(float v) {
#pragma unroll
    for (int o = 1; o < 64; o <<= 1) v += __shfl_xor(v, o);
    return v;
}
DI float fexp2(float x) { return __builtin_amdgcn_exp2f(x); }
DI float flog2(float x) { return __builtin_amdgcn_logf(x); }
DI float frcp(float x) { return __builtin_amdgcn_rcpf(x); }
DI float silu_f(float g) { return g * frcp(1.f + fexp2(-1.4426950408889634f * g)); }
DI float sigmoid_f(float g) { return frcp(1.f + fexp2(-1.4426950408889634f * g)); }
#define LBAR() do { asm volatile("s_waitcnt lgkmcnt(0)" ::: "memory"); __builtin_amdgcn_s_barrier(); asm volatile("" ::: "memory"); } while (0)
DI float half_sum(float v) { const unsigned u = __float_as_uint(v); auto rr = __builtin_amdgcn_permlane32_swap(u, u, false, false); return __uint_as_float(rr[0]) + __uint_as_float(rr[1]); }
DI float half_max(float v) { const unsigned u = __float_as_uint(v); auto rr = __builtin_amdgcn_permlane32_swap(u, u, false, false); return fmaxf(__uint_as_float(rr[0]), __uint_as_float(rr[1])); }
DI int crow(int r, int hi) { return (r & 3) + 8 * (r >> 2) + 4 * hi; }
#define MFMA32(a, b, c) __builtin_amdgcn_mfma_f32_32x32x16_bf16((a), (b), (c), 0, 0, 0)
#define MFMA16(a, b, c) __builtin_amdgcn_mfma_f32_16x16x32_bf16((a), (b), (c), 0, 0, 0)
DI bf16x8 pack8(const f32x16& x, int s) {
    u32x4 p;
    p.x = pk2(x[8 * s + 0], x[8 * s + 1]); p.y = pk2(x[8 * s + 2], x[8 * s + 3]); p.z = pk2(x[8 * s + 4], x[8 * s + 5]); p.w = pk2(x[8 * s + 6], x[8 * s + 7]);
    return __builtin_bit_cast(bf16x8, p);
}

constexpr int T_ = 16384, DM = 1024, SEQ = 4096, DFF = 2816, NIN = 3248, NINP = 3328;
constexpr float ALPHA = 1.4142135623730951f;
constexpr float LN_EPS = 1e-5f;
constexpr int C_GZ = 1536, C_GA = 2048, C_GB = 2056, C_SQ = 2064, C_SK = 2320, C_SV = 2576, C_MQ = 2832, C_CKV = 3088, C_KR = 3216;
constexpr size_t MiB = 1u << 20;
constexpr size_t WS_CTL = 0, WS_GL = 65536, WS_ROPE = 1 * MiB, WS_W = 3 * MiB, WS_AB = 48 * MiB, WS_G = 152 * MiB, WS_MQ = 232 * MiB, WS_MK = 244 * MiB, WS_MVT = 256 * MiB, WS_SVT = 264 * MiB, WS_END = 272 * MiB;
constexpr size_t WS_HB1 = WS_G + 32 * MiB, WS_PB = WS_AB + 96 * MiB;
constexpr size_t OW_A1 = 0, OW_A2 = 5767168, OW_B1 = 8650752, OW_B2 = 14417920, OW_MI = 17301504, OW_UQ = 20709376, OW_UKV = 20807680, OW_O = 20873216, OW_GT = 21921792, OW_P = 22970368;
constexpr int LDS_BYTES = 147456;
constexpr int GSLOT = 40960;

namespace pg8 {
constexpr int BM = 256, BK = 64, HALF = 128, HTB = HALF * BK * 2, STAGE_BYTES = 8 * HTB, NXCD = 8, WGM = 8;
DI int lds_byte(int r, int c) { const int st = (r >> 4) * 2 + (c >> 5), rr = r & 15, cc = c & 31, ob = rr * 64 + cc * 2; return st * 1024 + (ob ^ (((ob >> 9) & 1) << 5)); }
DI void stage_rc(int b, int& R, int& C) { const int st = b / 1024, sb = b % 1024, swz = sb ^ (((sb >> 9) & 1) << 5); R = (st >> 1) * 16 + swz / 64; C = (st & 1) * 32 + (swz % 64) / 2; }
DI int perm32(int rho) { const int n = rho >> 4, i = rho & 15; return 8 * (i >> 2) + 4 * n + (i & 3); }
struct Unit { int pm, pn; };
struct Gemm { const bf16_t* A; const bf16_t* Bt; int M, N, K, lda; };
struct StaticOrder {
    int nM, nN, nwg, G, c;
    DI void init(int M, int N, int G_, int c_) { nM = M / BM; nN = N / BM; nwg = nM * nN; G = G_; c = c_; }
    DI bool next(int i, Unit& u) const {
        const long L = (long)i * G + c; if (L >= nwg) return false;
        int wgid = (int)L; { const int q = nwg / NXCD, r = nwg % NXCD, xcd = wgid % NXCD, off = wgid / NXCD; wgid = (xcd < r ? xcd * (q + 1) : r * (q + 1) + (xcd - r) * q) + off; }
        const int nig = WGM * nN, gid = wgid / nig, fm = gid * WGM, gsz = (nM - fm) < WGM ? (nM - fm) : WGM;
        u.pm = fm + ((wgid % nig) % gsz); u.pn = (wgid % nig) / gsz; return true;
    }
};
struct EpiBf16 {
    static constexpr bool PERM = true, AFTER_DRAIN = false;
    bf16_t* O; int ldc;
    DI void operator()(const f32x4 (&acc)[2][2][4][2], const Unit& u, int wr, int wc, int fr, int fq) const {
        const int row0 = u.pm * BM + wr * 64 + fr; const int col0 = u.pn * BM + wc * 32 + 8 * fq;
#pragma unroll
        for (int ai = 0; ai < 2; ++ai)
#pragma unroll
            for (int m = 0; m < 4; ++m) { bf16_t* rowp = O + (size_t)(row0 + ai * HALF + m * 16) * ldc + col0;
#pragma unroll
                for (int bj = 0; bj < 2; ++bj) { const f32x4 v0 = acc[ai][bj][m][0], v1 = acc[ai][bj][m][1];
                    u32x4 w; w.x = pk2(v0[0], v0[1]); w.y = pk2(v0[2], v0[3]); w.z = pk2(v1[0], v1[1]); w.w = pk2(v1[2], v1[3]);
                    *(u32x4*)(rowp + bj * HALF) = w; } }
    }
};
struct EpiSwiGLU {
    static constexpr bool PERM = true, AFTER_DRAIN = false;
    bf16_t* O; int ldc;
    DI void operator()(const f32x4 (&acc)[2][2][4][2], const Unit& u, int wr, int wc, int fr, int fq) const {
        const int row0 = u.pm * BM + wr * 64 + fr; const int col0 = u.pn * HALF + wc * 32 + 8 * fq;
#pragma unroll
        for (int ai = 0; ai < 2; ++ai)
#pragma unroll
            for (int m = 0; m < 4; ++m) { bf16_t* rowp = O + (size_t)(row0 + ai * HALF + m * 16) * ldc + col0;
                float v[8];
#pragma unroll
                for (int n = 0; n < 2; ++n)
#pragma unroll
                    for (int e = 0; e < 4; ++e) v[4 * n + e] = silu_f(acc[ai][0][m][n][e]) * acc[ai][1][m][n][e];
                u32x4 w; w.x = pk2(v[0], v[1]); w.y = pk2(v[2], v[3]); w.z = pk2(v[4], v[5]); w.w = pk2(v[6], v[7]);
                *(u32x4*)rowp = w; }
    }
};
struct EpiResid {
    static constexpr bool PERM = false, AFTER_DRAIN = false;
    const float* Hin; float* H; int ldc; float alpha, s;
    DI void operator()(const f32x4 (&acc)[2][2][4][2], const Unit& u, int wr, int wc, int fr, int fq) const {
        const int col0 = u.pn * BM + wc * 32 + 4 * fq;
#pragma unroll
        for (int ai = 0; ai < 2; ++ai)
#pragma unroll
            for (int m = 0; m < 4; ++m) { const int r = u.pm * BM + ai * HALF + wr * 64 + m * 16 + fr; const size_t ro = (size_t)r * ldc + col0;
#pragma unroll
                for (int bj = 0; bj < 2; ++bj)
#pragma unroll
                    for (int n = 0; n < 2; ++n) { const f32x4 h = *(const f32x4*)(Hin + ro + bj * HALF + n * 16); *(f32x4*)(H + ro + bj * HALF + n * 16) = h * alpha + acc[ai][bj][m][n] * s; } }
    }
};
struct EpiPle {
    static constexpr bool PERM = false, AFTER_DRAIN = false;
    float* H; const bf16_t* PP; bf16_t* HB; int ldc;
    DI void operator()(const f32x4 (&acc)[2][2][4][2], const Unit& u, int wr, int wc, int fr, int fq) const {
        const int col0 = u.pn * BM + wc * 32 + 4 * fq;
#pragma unroll
        for (int ai = 0; ai < 2; ++ai)
#pragma unroll
            for (int m = 0; m < 4; ++m) { const int r = u.pm * BM + ai * HALF + wr * 64 + m * 16 + fr; const size_t ro = (size_t)r * ldc + col0;
#pragma unroll
                for (int bj = 0; bj < 2; ++bj)
#pragma unroll
                    for (int n = 0; n < 2; ++n) { const size_t off = ro + bj * HALF + n * 16; f32x4* p = (f32x4*)(H + off); const f32x4 h = *p; const u32x2 pw = *(const u32x2*)(PP + off);
                        const f32x4 a = acc[ai][bj][m][n]; f32x4 o;
                        o[0] = h[0] + sigmoid_f(a[0]) * bflo(pw.x); o[1] = h[1] + sigmoid_f(a[1]) * bfhi(pw.x); o[2] = h[2] + sigmoid_f(a[2]) * bflo(pw.y); o[3] = h[3] + sigmoid_f(a[3]) * bfhi(pw.y);
                        *p = o; u32x2 w; w.x = pk2(o[0], o[1]); w.y = pk2(o[2], o[3]); *(u32x2*)(HB + off) = w; } }
    }
};

struct EpiResidLn {
    static constexpr bool PERM = false, AFTER_DRAIN = true;
    const float* Hin; float* H; bf16_t* HB; int ldc; float alpha, s; const float* g; const float* b;
    unsigned long long* xbuf; unsigned* cnt;
    DI void fused(f32x4 (&acc)[2][2][4][2], const Unit& u, int wr, int wc, int fr_, int fq_, LAS unsigned char* lds, int wid, int lane_) const {
        int lane = lane_; asm volatile("" : "+v"(lane));
        const int fr = lane & 15, fq = lane >> 4;
        LAS f32x2* P = (LAS f32x2*)lds;
        LAS f32x2* S = (LAS f32x2*)(lds + 8192);
        const int col0 = u.pn * BM + wc * 32 + 4 * fq;
#pragma unroll
        for (int ai = 0; ai < 2; ++ai)
#pragma unroll
            for (int m = 0; m < 4; ++m) { const int r = u.pm * BM + ai * HALF + wr * 64 + m * 16 + fr; const size_t ro = (size_t)r * ldc + col0;
#pragma unroll
                for (int bj = 0; bj < 2; ++bj)
#pragma unroll
                    for (int n = 0; n < 2; ++n) { const f32x4 h = *(const f32x4*)(Hin + ro + bj * HALF + n * 16); acc[ai][bj][m][n] = h * alpha + acc[ai][bj][m][n] * s; }
                asm volatile("" : "+v"(acc[ai][0][m][0]), "+v"(acc[ai][0][m][1]), "+v"(acc[ai][1][m][0]), "+v"(acc[ai][1][m][1]));
                asm volatile("" ::: "memory"); }
#pragma unroll
        for (int ai = 0; ai < 2; ++ai)
#pragma unroll
            for (int m = 0; m < 4; ++m) {
                float sm = 0.f;
#pragma unroll
                for (int bj = 0; bj < 2; ++bj)
#pragma unroll
                    for (int n = 0; n < 2; ++n) { const f32x4 x = acc[ai][bj][m][n]; sm += (x[0] + x[1]) + (x[2] + x[3]); }
                sm += __shfl_xor(sm, 16); sm += __shfl_xor(sm, 32);
                const float mw = sm * (1.0f / 64.0f); float q = 0.f;
#pragma unroll
                for (int bj = 0; bj < 2; ++bj)
#pragma unroll
                    for (int n = 0; n < 2; ++n) { const f32x4 d = acc[ai][bj][m][n] - mw; q += (d[0] * d[0] + d[1] * d[1]) + (d[2] * d[2] + d[3] * d[3]); }
                q += __shfl_xor(q, 16); q += __shfl_xor(q, 32);
                if (fq == 0) P[(ai * HALF + wr * 64 + m * 16 + fr) * 4 + wc] = (f32x2){mw, q};
                __builtin_amdgcn_sched_barrier(0);
            }
        asm volatile("s_waitcnt lgkmcnt(0)" ::: "memory"); __builtin_amdgcn_s_barrier(); asm volatile("" ::: "memory");
        const int row = wid * 32 + (lane & 31);
        if (lane < 32) {
            const f32x2 a = P[row * 4 + 0], bb = P[row * 4 + 1], cc = P[row * 4 + 2], dd = P[row * 4 + 3];
            const float mt = (a[0] + bb[0] + cc[0] + dd[0]) * 0.25f;
            const float da = a[0] - mt, db = bb[0] - mt, dc = cc[0] - mt, de = dd[0] - mt;
            const float m2 = (a[1] + bb[1]) + (cc[1] + dd[1]) + 64.0f * ((da * da + db * db) + (dc * dc + de * de));
            unsigned long long* slot = xbuf + ((size_t)(u.pm * BM + row) * 4 + u.pn);
            __hip_atomic_store(slot, ((unsigned long long)__float_as_uint(m2) << 32) | __float_as_uint(mt), __ATOMIC_RELAXED, __HIP_MEMORY_SCOPE_AGENT);
        }
        asm volatile("s_waitcnt vmcnt(0)" ::: "memory");
        if (lane == 0) __hip_atomic_fetch_add(cnt + 64 * u.pm, 1u, __ATOMIC_RELAXED, __HIP_MEMORY_SCOPE_AGENT);
        if (wid == 0) {
            unsigned spins = 0;
            while ((unsigned)__builtin_amdgcn_readfirstlane(__hip_atomic_load(cnt + 64 * u.pm, __ATOMIC_RELAXED, __HIP_MEMORY_SCOPE_AGENT)) < 32u) { __builtin_amdgcn_s_sleep(2); if (++spins > (1u << 22)) break; }
            __builtin_amdgcn_fence(__ATOMIC_ACQUIRE, "agent");
        }
        asm volatile("s_waitcnt vmcnt(0) lgkmcnt(0)" ::: "memory"); __builtin_amdgcn_s_barrier(); asm volatile("" ::: "memory");
        if (lane < 32) {
            const unsigned long long* slot = xbuf + (size_t)(u.pm * BM + row) * 4; float mt[4], m2[4]; float ms = 0.f;
#pragma unroll
            for (int t = 0; t < 4; ++t) { const unsigned long long w = __hip_atomic_load(slot + t, __ATOMIC_RELAXED, __HIP_MEMORY_SCOPE_AGENT); mt[t] = __uint_as_float((unsigned)w); m2[t] = __uint_as_float((unsigned)(w >> 32)); ms += mt[t]; }
            const float mean = ms * 0.25f; float q = 0.f;
#pragma unroll
            for (int t = 0; t < 4; ++t) { const float dm = mt[t] - mean; q += m2[t] + 256.0f * dm * dm; }
            S[row] = (f32x2){mean, __builtin_amdgcn_rsqf(q * (1.0f / 1024.0f) + LN_EPS)};
        }
        asm volatile("s_waitcnt lgkmcnt(0)" ::: "memory"); __builtin_amdgcn_s_barrier(); asm volatile("" ::: "memory");
#pragma unroll
        for (int ai = 0; ai < 2; ++ai)
#pragma unroll
            for (int m = 0; m < 4; ++m) { const int rl = ai * HALF + wr * 64 + m * 16 + fr; const f32x2 sr = S[rl]; const size_t ro = (size_t)(u.pm * BM + rl) * ldc + col0;
#pragma unroll
                for (int bj = 0; bj < 2; ++bj)
#pragma unroll
                    for (int n = 0; n < 2; ++n) { const f32x4 gv = *(const f32x4*)(g + col0 + bj * HALF + n * 16), bv = *(const f32x4*)(b + col0 + bj * HALF + n * 16);
                        const f32x4 o = (acc[ai][bj][m][n] - sr[0]) * sr[1] * gv + bv;
                        *(f32x4*)(H + ro + bj * HALF + n * 16) = o; u32x2 w; w.x = pk2(o[0], o[1]); w.y = pk2(o[2], o[3]); *(u32x2*)(HB + ro + bj * HALF + n * 16) = w; }
                __builtin_amdgcn_sched_barrier(0); }
    }
};

template <class Epi, class Sched, bool ALIGN_EPI>
DI void gemm_phase(LAS unsigned char* lds, const Gemm g, const Sched& S, const Epi& E) {
    const int tid = threadIdx.x, wid = __builtin_amdgcn_readfirstlane(tid >> 6), lane = tid & 63, wr = wid >> 2, wc = wid & 3, fr = lane & 15, fq = lane >> 4;
    const int K = g.K, nt = K / BK, lda = g.lda;
    unsigned voffA[2], voffB[2];
#pragma unroll
    for (int i = 0; i < 2; ++i) { int R, C; stage_rc(tid * 16 + i * 8192, R, C); const int Rb = Epi::PERM ? ((R & ~31) + perm32(R & 31)) : R;
        voffA[i] = (unsigned)(R * lda + C) * 2u; voffB[i] = (unsigned)(Rb * K + C) * 2u; }
    const size_t kstep = (size_t)(BK * 2);
    const size_t hstepA = (size_t)HALF * lda * 2, tstepA = 2 * hstepA;
    const size_t hstepB = (size_t)HALF * K * 2, tstepB = 2 * hstepB;
    const unsigned ldsw = (unsigned)wid * 1024u;
    const int aoff = lds_byte(wr * 64 + fr, fq * 8), boff = lds_byte(wc * 32 + fr, fq * 8);
#define PG8_SA(b, h) (((b) * 2 + (h)) * HTB)
#define PG8_SB(b, h) ((4 + (b) * 2 + (h)) * HTB)
#define PG8_STAGE(bufoff, gbase, voff) do { _Pragma("unroll") for (int _i = 0; _i < 2; ++_i) \
        __builtin_amdgcn_global_load_lds((const unsigned*)((const char*)(gbase) + (voff)[_i]), (LAS unsigned*)(lds + (bufoff) + ldsw + _i * 8192), 16, 0, 0); } while (0)
#define PG8_LDA(dst, b, h) do { _Pragma("unroll") for (int m = 0; m < 4; ++m) _Pragma("unroll") for (int k = 0; k < 2; ++k) dst[m][k] = *(const LAS bf16x8*)(lds + PG8_SA(b, h) + aoff + m * 2048 + k * 1024); } while (0)
#define PG8_LDB(dst, b, h) do { _Pragma("unroll") for (int n = 0; n < 2; ++n) _Pragma("unroll") for (int k = 0; k < 2; ++k) dst[n][k] = *(const LAS bf16x8*)(lds + PG8_SB(b, h) + boff + n * 2048 + k * 1024); } while (0)
#define PG8_MMA(ai, bj, At, Bt) do { __builtin_amdgcn_s_setprio(1); _Pragma("unroll") for (int m = 0; m < 4; ++m) _Pragma("unroll") for (int n = 0; n < 2; ++n) _Pragma("unroll") for (int k = 0; k < 2; ++k) \
        acc[ai][bj][m][n] = __builtin_amdgcn_mfma_f32_16x16x32_bf16(Bt[n][k], At[m][k], acc[ai][bj][m][n], 0, 0, 0); __builtin_amdgcn_s_setprio(0); } while (0)
#define PG8_WAIT_V(n) asm volatile("s_waitcnt vmcnt(" #n ")" ::: "memory")
#define PG8_WAIT_L(n) asm volatile("s_waitcnt lgkmcnt(" #n ")" ::: "memory")
#define PG8_BAR __builtin_amdgcn_s_barrier()
#define PG8_SCHED __builtin_amdgcn_sched_barrier(0)
    Unit cur, nxt; int ui = 0;
    if (!S.next(0, cur)) return;
    f32x4 acc[2][2][4][2];
#pragma unroll
    for (int a = 0; a < 2; ++a)
#pragma unroll
        for (int b = 0; b < 2; ++b)
#pragma unroll
            for (int m = 0; m < 4; ++m)
#pragma unroll
                for (int n = 0; n < 2; ++n) acc[a][b][m][n] = (f32x4){0.f, 0.f, 0.f, 0.f};
    bf16x8 At[4][2], B0[2][2], B1[2][2];
    const char* cA = (const char*)g.A + (size_t)cur.pm * tstepA; const char* cB = (const char*)g.Bt + (size_t)cur.pn * tstepB;
    PG8_STAGE(PG8_SB(0, 0), cB, voffB); PG8_STAGE(PG8_SB(0, 1), cB + hstepB, voffB); PG8_STAGE(PG8_SA(0, 0), cA, voffA); PG8_STAGE(PG8_SA(0, 1), cA + hstepA, voffA);
    if (wr == 1) PG8_BAR;
    PG8_WAIT_V(2); PG8_BAR;
    PG8_STAGE(PG8_SB(1, 0), cB + kstep, voffB); PG8_STAGE(PG8_SA(1, 0), cA + kstep, voffA); PG8_STAGE(PG8_SB(1, 1), cB + hstepB + kstep, voffB);
    PG8_WAIT_V(6); PG8_BAR;
    for (;;) {
        const bool has_next = S.next(ui + 1, nxt);
        const char* nA = has_next ? (const char*)g.A + (size_t)nxt.pm * tstepA : cA; const char* nB = has_next ? (const char*)g.Bt + (size_t)nxt.pn * tstepB : cB;
        for (int t = 0; t < nt; t += 2) {
            const bool last = (t == nt - 2);
            const char* a1 = cA + (size_t)(t + 1) * kstep;
            const char* a2 = last ? nA : cA + (size_t)(t + 2) * kstep; const char* b2 = last ? nB : cB + (size_t)(t + 2) * kstep;
            const char* a3 = a2 + kstep; const char* b3 = b2 + kstep;
            PG8_LDB(B0, 0, 0); PG8_LDB(B1, 0, 1); PG8_SCHED; PG8_LDA(At, 0, 0); PG8_STAGE(PG8_SA(1, 1), a1 + hstepA, voffA);
            PG8_WAIT_V(8); PG8_WAIT_L(0); PG8_BAR; PG8_MMA(0, 0, At, B0); PG8_MMA(0, 1, At, B1); PG8_BAR; PG8_SCHED;
            PG8_LDA(At, 0, 1); PG8_STAGE(PG8_SB(0, 0), b2, voffB); PG8_STAGE(PG8_SB(0, 1), b2 + hstepB, voffB); PG8_STAGE(PG8_SA(0, 0), a2, voffA);
            PG8_WAIT_V(8); PG8_WAIT_L(0); PG8_BAR; PG8_MMA(1, 0, At, B0); PG8_MMA(1, 1, At, B1); PG8_BAR; PG8_SCHED;
            PG8_LDB(B0, 1, 0); PG8_LDB(B1, 1, 1); PG8_SCHED; PG8_LDA(At, 1, 0); PG8_STAGE(PG8_SA(0, 1), a2 + hstepA, voffA);
            PG8_WAIT_V(8); PG8_WAIT_L(0); PG8_BAR; PG8_MMA(0, 0, At, B0); PG8_MMA(0, 1, At, B1); PG8_BAR; PG8_SCHED;
            PG8_LDA(At, 1, 1); PG8_STAGE(PG8_SB(1, 0), b3, voffB); PG8_STAGE(PG8_SB(1, 1), b3 + hstepB, voffB); PG8_STAGE(PG8_SA(1, 0), a3, voffA);
            PG8_WAIT_V(8); PG8_WAIT_L(0); PG8_BAR; PG8_MMA(1, 0, At, B0); PG8_MMA(1, 1, At, B1); PG8_BAR; PG8_SCHED;
        }
        if constexpr (ALIGN_EPI) { if (wr == 0) PG8_BAR; }
        if constexpr (!Epi::AFTER_DRAIN) E(acc, cur, wr, wc, fr, fq);
        if (!has_next) break;
#pragma unroll
        for (int a = 0; a < 2; ++a)
#pragma unroll
            for (int b = 0; b < 2; ++b)
#pragma unroll
                for (int m = 0; m < 4; ++m)
#pragma unroll
                    for (int n = 0; n < 2; ++n) acc[a][b][m][n] = (f32x4){0.f, 0.f, 0.f, 0.f};
        cur = nxt; cA = nA; cB = nB; ++ui;
        if constexpr (ALIGN_EPI) { if (wr == 1) PG8_BAR; }
    }
    PG8_WAIT_V(0);
    if constexpr (!ALIGN_EPI) { if (wr == 0) PG8_BAR; }
    PG8_BAR;
    if constexpr (Epi::AFTER_DRAIN) E.fused(acc, cur, wr, wc, fr, fq, lds, wid, lane);
#undef PG8_SA
#undef PG8_SB
#undef PG8_STAGE
#undef PG8_LDA
#undef PG8_LDB
#undef PG8_MMA
#undef PG8_WAIT_V
#undef PG8_WAIT_L
#undef PG8_BAR
#undef PG8_SCHED
}
}

struct Ctx { LAS unsigned char* lds; int tid, lane, wid, G, bid; };

DI void conv_item(const float* W, int K, int Nsrc, bf16_t* WT, int mode, LAS float* scr, int item, int nblk, int lane) {
    const int kb = item / nblk, nb = item % nblk, k0 = 64 * kb, n0 = 32 * nb;
    const int n = n0 + (lane & 31);
    int src = n; bool ok = n < Nsrc;
    if (mode == 1) { const int pn = n >> 8, bj = (n >> 7) & 1, jj = n & 127; src = bj * DFF + pn * 128 + jj; ok = true; }
    float wv[32];
    const int srcc = ok ? src : 0;
#pragma unroll
    for (int i = 0; i < 32; ++i) { const int kk = 2 * i + (lane >> 5); wv[i] = W[(size_t)(k0 + kk) * Nsrc + srcc]; }
#pragma unroll
    for (int i = 0; i < 32; ++i) { const int kk = 2 * i + (lane >> 5); scr[kk * 33 + (lane & 31)] = ok ? wv[i] : 0.f; }
    asm volatile("s_waitcnt lgkmcnt(0)" ::: "memory");
    const int c = lane & 7;
#pragma unroll
    for (int j = 0; j < 4; ++j) { const int nn = (lane >> 3) + 8 * j; const LAS float* s = scr + (8 * c) * 33 + nn;
        u32x4 o; o.x = pk2(s[0 * 33], s[1 * 33]); o.y = pk2(s[2 * 33], s[3 * 33]); o.z = pk2(s[4 * 33], s[5 * 33]); o.w = pk2(s[6 * 33], s[7 * 33]);
        *(u32x4*)(WT + (size_t)(n0 + nn) * K + k0 + 8 * c) = o; }
    asm volatile("s_waitcnt lgkmcnt(0)" ::: "memory");
}

struct LayerW { const float *a1, *a2, *mi, *uq, *ukv, *wo, *b1, *b2, *gt, *pp; };
template <int SET> DI void conv_phase(const Ctx& c, const LayerW& L, bf16_t* W, const int gw, const int NGW) {
    LAS float* scr = (LAS float*)(c.lds + c.wid * 8448);
    constexpr int I_A1 = 16 * 176, I_A2 = 44 * 32, I_MI = 16 * 104, I_UQ = 4 * 12, I_UKV = 2 * 16, I_O = 16 * 32, I_P = 4 * 32;
    constexpr int NITEMS = SET == 0 ? I_A1 + I_A2 : SET == 1 ? I_MI + I_UQ + I_UKV + I_O : I_A1 + I_A2 + I_O + I_P;
    for (int it = gw; it < NITEMS; it += NGW) {
        int r = it;
        if constexpr (SET == 0) {
            if (r < I_A1) { conv_item(L.a1, 1024, 5632, W + OW_A1, 1, scr, r, 176, c.lane); continue; } r -= I_A1;
            conv_item(L.a2, 2816, 1024, W + OW_A2, 0, scr, r, 32, c.lane);
        } else if constexpr (SET == 1) {
            if (r < I_MI) { conv_item(L.mi, 1024, NIN, W + OW_MI, 0, scr, r, 104, c.lane); continue; } r -= I_MI;
            if (r < I_UQ) { conv_item(L.uq, 256, 384, W + OW_UQ, 0, scr, r, 12, c.lane); continue; } r -= I_UQ;
            if (r < I_UKV) { conv_item(L.ukv, 128, 512, W + OW_UKV, 0, scr, r, 16, c.lane); continue; } r -= I_UKV;
            conv_item(L.wo, 1024, 1024, W + OW_O, 0, scr, r, 32, c.lane);
        } else {
            if (r < I_A1) { conv_item(L.b1, 1024, 5632, W + OW_B1, 1, scr, r, 176, c.lane); continue; } r -= I_A1;
            if (r < I_A2) { conv_item(L.b2, 2816, 1024, W + OW_B2, 0, scr, r, 32, c.lane); continue; } r -= I_A2;
            if (r < I_O) { conv_item(L.gt, 1024, 1024, W + OW_GT, 0, scr, r, 32, c.lane); continue; } r -= I_O;
            conv_item(L.pp, 256, 1024, W + OW_P, 0, scr, r, 32, c.lane);
        }
    }
}

DI void ln_phase(const Ctx& c, float* H, bf16_t* HB, const float* g, const float* b) {
    const int gw = c.bid * 8 + c.wid, NGW = c.G * 8;
    for (int m = 2 * gw; m < T_; m += 2 * NGW) {
        f32x4* xr0 = (f32x4*)(H + (size_t)m * DM) + c.lane; f32x4* xr1 = xr0 + DM / 4;
        f32x4 v0[4], v1[4]; float s0 = 0.f, q0 = 0.f, s1 = 0.f, q1 = 0.f;
#pragma unroll
        for (int j = 0; j < 4; ++j) { v0[j] = xr0[64 * j]; v1[j] = xr1[64 * j]; }
#pragma unroll
        for (int j = 0; j < 4; ++j) { s0 += (v0[j][0] + v0[j][1]) + (v0[j][2] + v0[j][3]); q0 += (v0[j][0] * v0[j][0] + v0[j][1] * v0[j][1]) + (v0[j][2] * v0[j][2] + v0[j][3] * v0[j][3]);
            s1 += (v1[j][0] + v1[j][1]) + (v1[j][2] + v1[j][3]); q1 += (v1[j][0] * v1[j][0] + v1[j][1] * v1[j][1]) + (v1[j][2] * v1[j][2] + v1[j][3] * v1[j][3]); }
#pragma unroll
        for (int o = 1; o < 64; o <<= 1) { s0 += __shfl_xor(s0, o); q0 += __shfl_xor(q0, o); s1 += __shfl_xor(s1, o); q1 += __shfl_xor(q1, o); }
        const float mean0 = s0 * (1.f / DM), mean1 = s1 * (1.f / DM);
        const float rstd0 = __builtin_amdgcn_rsqf(fmaxf(q0 * (1.f / DM) - mean0 * mean0, 0.f) + LN_EPS), rstd1 = __builtin_amdgcn_rsqf(fmaxf(q1 * (1.f / DM) - mean1 * mean1, 0.f) + LN_EPS);
        u32x2* o80 = (u32x2*)(HB + (size_t)m * DM) + c.lane; u32x2* o81 = o80 + DM / 4;
#pragma unroll
        for (int j = 0; j < 4; ++j) { const f32x4 gg = ((const f32x4*)g)[c.lane + 64 * j], bb = ((const f32x4*)b)[c.lane + 64 * j];
            const f32x4 a0 = (v0[j] - mean0) * rstd0 * gg + bb, a1 = (v1[j] - mean1) * rstd1 * gg + bb; xr0[64 * j] = a0; xr1[64 * j] = a1;
            u32x2 w0; w0.x = pk2(a0[0], a0[1]); w0.y = pk2(a0[2], a0[3]); o80[64 * j] = w0; u32x2 w1; w1.x = pk2(a1[0], a1[1]); w1.y = pk2(a1[2], a1[3]); o81[64 * j] = w1; }
    }
}
DI void cvt_phase(const Ctx& c, const float* src, bf16_t* dst, float* copy, size_t n) {
    const size_t n4 = n / 4, stride = (size_t)c.G * 512;
    for (size_t i = (size_t)c.bid * 512 + c.tid; i < n4; i += stride) { const f32x4 v = ((const f32x4*)src)[i]; u32x2 w; w.x = pk2(v[0], v[1]); w.y = pk2(v[2], v[3]); ((u32x2*)dst)[i] = w; if (copy) ((f32x4*)copy)[i] = v; }
}
DI void rope_phase(const Ctx& c, const int* pos, f32x2* RT) {
    for (int i = c.bid * 512 + c.tid; i < T_ * 16; i += c.G * 512) {
        const int t = i >> 4, f = i & 15;
        const float e = (float)(2 * f) / 32.0f;
        const float pw = (float)exp2((double)e * 13.287712379549449);
        const float inv = 1.0f / pw;
        const float ang = (float)pos[t] * inv;
        const double rev = (double)ang * 0.15915494309189535; const float fr = (float)(rev - floor(rev));
        RT[i] = (f32x2){__builtin_amdgcn_cosf(fr), __builtin_amdgcn_sinf(fr)};
    }
}

DI void gdn_prefetch(const Ctx& c, int item, const bf16_t* proj, u32x4 (&x)[12], bf16_t& ga, bf16_t& gb) {
    const int tid = c.tid; const int b = item >> 9, h = (item >> 6) & 7, n = item & 63; const int t = tid >> 3, cg8 = tid & 7;
#pragma unroll
    for (int which = 0; which < 3; ++which)
#pragma unroll
        for (int j = 0; j < 4; ++j) { const int sp = n * 64 + t - 3 + j; const int spc = sp >= 0 ? sp : 0;
            x[which * 4 + j] = *(const u32x4*)(proj + (size_t)(b * SEQ + spc) * NINP + which * 512 + h * 64 + cg8 * 8); }
    const size_t ro = (size_t)(b * SEQ + n * 64 + (tid & 63)) * NINP; ga = proj[ro + C_GA + h]; gb = proj[ro + C_GB + h];
}
DI void gdn_prep_item(const Ctx& c, int item, int next_item, u32x4 (&xin)[12], bf16_t& gain, bf16_t& gbin, const bf16_t* proj, const float* conv_w, const float* a_log, const float* dt_bias, unsigned char* gbase, float* GL, const int stop = 0) {
    const int tid = c.tid, lane = c.lane, wid = c.wid;
    const int b = item >> 9, h = (item >> 6) & 7, n = item & 63;
    const int tok0 = b * SEQ + n * 64;
    LAS float* qc = (LAS float*)c.lds; LAS float* kc = qc + 64 * 68; LAS float* vc = kc + 64 * 68; LAS float* Lm = vc + 64 * 68; LAS float* rhs = Lm + 64 * 68; LAS float* gcs = rhs + 64 * 132; LAS float* bet = gcs + 64;
    LAS bf16_t* KH = (LAS bf16_t*)(bet + 64); LAS bf16_t* KL = KH + 64 * 72; LAS bf16_t* QH = KL + 64 * 72; LAS bf16_t* QL = QH + 64 * 72;
    unsigned char* gout = gbase + (size_t)item * GSLOT;
#pragma unroll
    for (int which = 0; which < 3; ++which) {
        const int t = tid >> 3, cg8 = tid & 7; const int col = which * 512 + h * 64 + cg8 * 8;
        float acc[8];
#pragma unroll
        for (int e = 0; e < 8; ++e) acc[e] = 0.f;
#pragma unroll
        for (int j = 0; j < 4; ++j) { const int sp = n * 64 + t - 3 + j; const float ok = sp >= 0 ? 1.f : 0.f;
            const u32x4 xv = xin[which * 4 + j];
            const f32x4 w0 = *(const f32x4*)(conv_w + j * 1536 + col) * ok, w1 = *(const f32x4*)(conv_w + j * 1536 + col + 4) * ok;
            acc[0] += w0[0] * bflo(xv.x); acc[1] += w0[1] * bfhi(xv.x); acc[2] += w0[2] * bflo(xv.y); acc[3] += w0[3] * bfhi(xv.y);
            acc[4] += w1[0] * bflo(xv.z); acc[5] += w1[1] * bfhi(xv.z); acc[6] += w1[2] * bflo(xv.w); acc[7] += w1[3] * bfhi(xv.w); }
#pragma unroll
        for (int e = 0; e < 8; ++e) acc[e] = silu_f(acc[e]);
        if (which == 2) { LAS float* dst = vc + t * 68 + cg8 * 8; *(LAS f32x4*)dst = (f32x4){acc[0], acc[1], acc[2], acc[3]}; *(LAS f32x4*)(dst + 4) = (f32x4){acc[4], acc[5], acc[6], acc[7]}; }
        else {
            float ss = (acc[0] * acc[0] + acc[1] * acc[1]) + (acc[2] * acc[2] + acc[3] * acc[3]) + (acc[4] * acc[4] + acc[5] * acc[5]) + (acc[6] * acc[6] + acc[7] * acc[7]);
            ss += __shfl_xor(ss, 1); ss += __shfl_xor(ss, 2); ss += __shfl_xor(ss, 4);
            const float sc = (which ? 1.0f : 0.125f) * __builtin_amdgcn_rsqf(ss + 1e-6f);
            const f32x4 y0 = (f32x4){acc[0], acc[1], acc[2], acc[3]} * sc, y1 = (f32x4){acc[4], acc[5], acc[6], acc[7]} * sc;
            LAS float* dst = (which ? kc : qc) + t * 68 + cg8 * 8; *(LAS f32x4*)dst = y0; *(LAS f32x4*)(dst + 4) = y1;
            u32x4 hh; hh.x = pk2(y0[0], y0[1]); hh.y = pk2(y0[2], y0[3]); hh.z = pk2(y1[0], y1[1]); hh.w = pk2(y1[2], y1[3]);
            u32x4 lo; lo.x = pk2(y0[0] - bflo(hh.x), y0[1] - bfhi(hh.x)); lo.y = pk2(y0[2] - bflo(hh.y), y0[3] - bfhi(hh.y)); lo.z = pk2(y1[0] - bflo(hh.z), y1[1] - bfhi(hh.z)); lo.w = pk2(y1[2] - bflo(hh.w), y1[3] - bfhi(hh.w));
            *(LAS u32x4*)((which ? KH : QH) + t * 72 + cg8 * 8) = hh; *(LAS u32x4*)((which ? KL : QL) + t * 72 + cg8 * 8) = lo; }
    }
    { const float ga = bf2f(gain), gb = bf2f(gbin);
        const float x = ga + dt_bias[h]; const float sp = fmaxf(x, 0.f) + log1pf(expf(-fabsf(x)));
        float gv = -expf(a_log[h]) * sp; const float bv = 1.f / (1.f + expf(-gb));
        if (wid == 0) {
#pragma unroll
            for (int o = 1; o < 64; o <<= 1) { const float tt = __shfl_up(gv, o); if (lane >= o) gv += tt; }
            gcs[lane] = gv; bet[lane] = bv; } }
    LBAR();
    if (stop == 3) return;
    LAS float* DIV = (LAS float*)(c.lds + 140800);
    const float glog = gcs[63];
    gdn_prefetch(c, next_item, proj, xin, gain, gbin);
    { const int l31 = lane & 31, hi = lane >> 5; const int isqk = wid >> 2, jt = (wid >> 1) & 1, it = wid & 1;
        if (jt <= it) {
            const LAS bf16_t* BH = isqk ? QH : KH; const LAS bf16_t* BL = isqk ? QL : KL;
            bf16x8 aH[4], aLo[4], bH[4], bLo[4];
#pragma unroll
            for (int ks = 0; ks < 4; ++ks) { const int ao = (32 * jt + l31) * 72 + 16 * ks + 8 * hi, bo = (32 * it + l31) * 72 + 16 * ks + 8 * hi;
                aH[ks] = *(const LAS bf16x8*)(KH + ao); aLo[ks] = *(const LAS bf16x8*)(KL + ao); bH[ks] = *(const LAS bf16x8*)(BH + bo); bLo[ks] = *(const LAS bf16x8*)(BL + bo); }
            __builtin_amdgcn_sched_barrier(0);
            f32x16 acc;
#pragma unroll
            for (int r = 0; r < 16; ++r) acc[r] = 0.f;
#pragma unroll
            for (int ks = 0; ks < 4; ++ks) { acc = MFMA32(aH[ks], bH[ks], acc); acc = MFMA32(aH[ks], bLo[ks], acc); acc = MFMA32(aLo[ks], bH[ks], acc); }
            const int i = 32 * it + l31; const float gi = gcs[i], bi = bet[i];
#pragma unroll
            for (int r = 0; r < 16; ++r) { const int j = 32 * jt + crow(r, hi); const float d = fexp2((gi - gcs[j]) * 1.4426950408889634f);
                if (isqk) acc[r] = (j <= i) ? acc[r] * d : 0.f; else Lm[j * 68 + i] = (j < i) ? bi * acc[r] * d : 0.f; }
            if (isqk) {
#pragma unroll
                for (int sx = 0; sx < 2; ++sx) { const bf16x8 pk = pack8(acc, sx); *(u32x4*)(gout + 2 * 8192 + ((it * 4 + 2 * jt + sx) * 64 + lane) * 16) = __builtin_bit_cast(u32x4, pk); } }
            else if (jt == it) {
                const int bb = 2 * jt + ((lane >> 4) & 1), col = lane & 15;
                float y[16];
#pragma unroll
                for (int ii = 0; ii < 16; ++ii) y[ii] = (ii == col) ? 1.f : 0.f;
#pragma unroll
                for (int j = 0; j < 15; ++j) { const float yj = y[j];
#pragma unroll
                    for (int q4 = (j + 1) / 4; q4 < 4; ++q4) { const f32x4 l4 = *(const LAS f32x4*)(Lm + (16 * bb + j) * 68 + 16 * bb + 4 * q4);
#pragma unroll
                        for (int e = 0; e < 4; ++e) if (4 * q4 + e > j) y[4 * q4 + e] -= l4[e] * yj; } }
#pragma unroll
                for (int ii = 0; ii < 16; ++ii) DIV[bb * 320 + ii * 20 + col] = y[ii];
            }
        } else if (isqk) {
#pragma unroll
            for (int sx = 0; sx < 2; ++sx) *(u32x4*)(gout + 2 * 8192 + ((it * 4 + 2 * jt + sx) * 64 + lane) * 16) = (u32x4){0u, 0u, 0u, 0u};
        }
    }
#pragma unroll 2
    for (int e = tid; e < 8192; e += 512) { const int i = e >> 7, cc = e & 127; const float bi = bet[i];
        rhs[i * 132 + cc] = cc < 64 ? vc[i * 68 + cc] * bi : kc[i * 68 + cc - 64] * bi * fexp2(gcs[i] * 1.4426950408889634f); }
#pragma unroll 1
    for (int q = 0; q < 2; ++q) { const int ch = tid + 512 * q; const int mat = ch < 512 ? 1 : 3, idx = ch & 511;
        const int mt = idx >> 8, ks = (idx >> 6) & 3, ln = idx & 63, i = 32 * mt + (ln & 31), hh = ln >> 5, k0 = 16 * ks + 4 * hh;
        float v[8];
        if (mat == 1) { const float e = fexp2(gcs[i] * 1.4426950408889634f); const f32x4 a = *(const LAS f32x4*)(qc + i * 68 + k0), bq = *(const LAS f32x4*)(qc + i * 68 + k0 + 8);
#pragma unroll
            for (int x = 0; x < 4; ++x) { v[x] = a[x] * e; v[4 + x] = bq[x] * e; } }
        else {
#pragma unroll
            for (int x = 0; x < 8; ++x) { const int cr = k0 + (x & 3) + 8 * (x >> 2); v[x] = kc[cr * 68 + i] * fexp2((glog - gcs[cr]) * 1.4426950408889634f); } }
        u32x4 w; w.x = pk2(v[0], v[1]); w.y = pk2(v[2], v[3]); w.z = pk2(v[4], v[5]); w.w = pk2(v[6], v[7]);
        *(u32x4*)(gout + mat * 8192 + idx * 16) = w; }
    LBAR();
    if (stop == 4) return;
    {
        const int g = lane >> 4, nn = lane & 15, cb = 16 * wid + nn;
#pragma unroll
        for (int blk = 0; blk < 4; ++blk) {
            f32x4 acc;
#pragma unroll
            for (int r = 0; r < 4; ++r) acc[r] = rhs[(16 * blk + 4 * g + r) * 132 + cb];
#pragma unroll
            for (int k4 = 0; k4 < 4 * blk; ++k4) { const float av = -Lm[(4 * k4 + g) * 68 + 16 * blk + nn], bv = rhs[(4 * k4 + g) * 132 + cb];
                acc = __builtin_amdgcn_mfma_f32_16x16x4f32(av, bv, acc, 0, 0, 0); }
#pragma unroll
            for (int r = 0; r < 4; ++r) rhs[(16 * blk + 4 * g + r) * 132 + cb] = acc[r];
            f32x4 xs = (f32x4){0.f, 0.f, 0.f, 0.f};
#pragma unroll
            for (int k4 = 0; k4 < 4; ++k4) { const float av = DIV[blk * 320 + nn * 20 + 4 * k4 + g], bv = rhs[(16 * blk + 4 * k4 + g) * 132 + cb];
                xs = __builtin_amdgcn_mfma_f32_16x16x4f32(av, bv, xs, 0, 0, 0); }
#pragma unroll
            for (int r = 0; r < 4; ++r) rhs[(16 * blk + 4 * g + r) * 132 + cb] = xs[r];
        }
    }
    LBAR();
    if (stop == 5) return;
    {
        const int idx = tid; const int mt = idx >> 8, ks = (idx >> 6) & 3, ln = idx & 63, i = 32 * mt + (ln & 31), hh = ln >> 5, k0 = 16 * ks + 4 * hh;
        const f32x4 a = *(const LAS f32x4*)(rhs + i * 132 + 64 + k0), bq = *(const LAS f32x4*)(rhs + i * 132 + 64 + k0 + 8);
        u32x4 w; w.x = pk2(-a[0], -a[1]); w.y = pk2(-a[2], -a[3]); w.z = pk2(-bq[0], -bq[1]); w.w = pk2(-bq[2], -bq[3]);
        *(u32x4*)(gout + idx * 16) = w;
        const int tile = idx >> 7, ln2 = (idx >> 1) & 63, half = idx & 1, ct = tile >> 1, vt = tile & 1, vcol = 32 * vt + (ln2 & 31), h2 = ln2 >> 5;
        float v[8];
#pragma unroll
        for (int e = 0; e < 8; ++e) { const int r = 8 * half + e; v[e] = rhs[(32 * ct + crow(r, h2)) * 132 + vcol]; }
        u32x4 wu; wu.x = pk2(v[0], v[1]); wu.y = pk2(v[2], v[3]); wu.z = pk2(v[4], v[5]); wu.w = pk2(v[6], v[7]);
        *(u32x4*)(gout + 4 * 8192 + idx * 16) = wu;
        if (tid == 0) GL[item] = expf(glog);
    }
}

DI int pos16(int t) { const int x = t & 15; return (t & ~15) | (8 * ((x >> 2) & 1) + 4 * (x >> 3) + (x & 3)); }
DI void mla_prep_item(const Ctx& c, int item, const bf16_t* proj, const float* qnw, const float* kvnw, const bf16_t* Wuq, const bf16_t* Wukv, const f32x2* RT,
                      bf16_t* MQ, bf16_t* MK, bf16_t* MVT, bf16_t* SVT) {
    const int tid = c.tid, lane = c.lane, wid = c.wid;
    const int tok0 = item * 64, b = item >> 6, s0 = (item & 63) * 64;
    LAS bf16_t* A1 = (LAS bf16_t*)c.lds;
    LAS bf16_t* A2 = (LAS bf16_t*)(c.lds + 33792);
    LAS bf16_t* OUT = (LAS bf16_t*)(c.lds + 51200);
    LAS bf16_t* VT = (LAS bf16_t*)(c.lds + 101376);
    LBAR();
    { const int row = 8 * wid + (lane >> 3), ch = lane & 7; const size_t ro = (size_t)(tok0 + row) * NINP;
        u32x4 xq[4], xk[2];
#pragma unroll
        for (int q = 0; q < 4; ++q) xq[q] = *(const u32x4*)(proj + ro + C_MQ + ch * 32 + q * 8);
#pragma unroll
        for (int q = 0; q < 2; ++q) xk[q] = *(const u32x4*)(proj + ro + C_CKV + ch * 16 + q * 8);
        const unsigned r1 = *(const unsigned*)(proj + ro + C_KR + 2 * ch), r2 = *(const unsigned*)(proj + ro + C_KR + 16 + 2 * ch);
        const f32x4 cs = *(const f32x4*)(RT + (size_t)(tok0 + row) * 16 + 2 * ch);
        float ss = 0.f, sk = 0.f;
#pragma unroll
        for (int q = 0; q < 4; ++q) { ss += bflo(xq[q].x) * bflo(xq[q].x) + bfhi(xq[q].x) * bfhi(xq[q].x) + bflo(xq[q].y) * bflo(xq[q].y) + bfhi(xq[q].y) * bfhi(xq[q].y)
                                          + bflo(xq[q].z) * bflo(xq[q].z) + bfhi(xq[q].z) * bfhi(xq[q].z) + bflo(xq[q].w) * bflo(xq[q].w) + bfhi(xq[q].w) * bfhi(xq[q].w); }
#pragma unroll
        for (int q = 0; q < 2; ++q) { sk += bflo(xk[q].x) * bflo(xk[q].x) + bfhi(xk[q].x) * bfhi(xk[q].x) + bflo(xk[q].y) * bflo(xk[q].y) + bfhi(xk[q].y) * bfhi(xk[q].y)
                                          + bflo(xk[q].z) * bflo(xk[q].z) + bfhi(xk[q].z) * bfhi(xk[q].z) + bflo(xk[q].w) * bflo(xk[q].w) + bfhi(xk[q].w) * bfhi(xk[q].w); }
        ss += __shfl_xor(ss, 1); sk += __shfl_xor(sk, 1); ss += __shfl_xor(ss, 2); sk += __shfl_xor(sk, 2); ss += __shfl_xor(ss, 4); sk += __shfl_xor(sk, 4);
        const float rq = __builtin_amdgcn_rsqf(ss * (1.f / 256.f) + 1e-6f), rk = __builtin_amdgcn_rsqf(sk * (1.f / 128.f) + 1e-6f);
        __builtin_amdgcn_sched_barrier(0);
#pragma unroll
        for (int q = 0; q < 4; ++q) { const f32x4 n0 = *(const f32x4*)(qnw + ch * 32 + q * 8), n1 = *(const f32x4*)(qnw + ch * 32 + q * 8 + 4); u32x4 o;
            o.x = pk2(bflo(xq[q].x) * rq * n0[0], bfhi(xq[q].x) * rq * n0[1]); o.y = pk2(bflo(xq[q].y) * rq * n0[2], bfhi(xq[q].y) * rq * n0[3]);
            o.z = pk2(bflo(xq[q].z) * rq * n1[0], bfhi(xq[q].z) * rq * n1[1]); o.w = pk2(bflo(xq[q].w) * rq * n1[2], bfhi(xq[q].w) * rq * n1[3]);
            *(LAS u32x4*)(A1 + row * 264 + ch * 32 + q * 8) = o; __builtin_amdgcn_sched_barrier(0); }
#pragma unroll
        for (int q = 0; q < 2; ++q) { const f32x4 n0 = *(const f32x4*)(kvnw + ch * 16 + q * 8), n1 = *(const f32x4*)(kvnw + ch * 16 + q * 8 + 4); u32x4 o;
            o.x = pk2(bflo(xk[q].x) * rk * n0[0], bfhi(xk[q].x) * rk * n0[1]); o.y = pk2(bflo(xk[q].y) * rk * n0[2], bfhi(xk[q].y) * rk * n0[3]);
            o.z = pk2(bflo(xk[q].z) * rk * n1[0], bfhi(xk[q].z) * rk * n1[1]); o.w = pk2(bflo(xk[q].w) * rk * n1[2], bfhi(xk[q].w) * rk * n1[3]);
            *(LAS u32x4*)(A2 + row * 136 + ch * 16 + q * 8) = o; __builtin_amdgcn_sched_barrier(0); }
        { const float x1a = bflo(r1), x1b = bfhi(r1), x2a = bflo(r2), x2b = bfhi(r2);
            const unsigned y1 = pk2(x1a * cs[0] - x2a * cs[1], x1b * cs[2] - x2b * cs[3]), y2 = pk2(x2a * cs[0] + x1a * cs[1], x2b * cs[2] + x1b * cs[3]);
#pragma unroll
            for (int hh = 0; hh < 4; ++hh) { *(unsigned*)(MK + (size_t)(tok0 + row) * 384 + hh * 96 + 64 + 2 * ch) = y1; *(unsigned*)(MK + (size_t)(tok0 + row) * 384 + hh * 96 + 80 + 2 * ch) = y2; } }
    }
#pragma unroll
    for (int q = 0; q < 4; ++q) { const int ch = tid + 512 * q, t = ch & 63, c8 = ch >> 6; const u32x4 w = *(const u32x4*)(proj + (size_t)(tok0 + t) * NINP + C_SV + c8 * 8); const int p = pos16(t);
        VT[(c8 * 8 + 0) * 72 + p] = (bf16_t)(w.x & 0xffff); VT[(c8 * 8 + 1) * 72 + p] = (bf16_t)(w.x >> 16); VT[(c8 * 8 + 2) * 72 + p] = (bf16_t)(w.y & 0xffff); VT[(c8 * 8 + 3) * 72 + p] = (bf16_t)(w.y >> 16);
        VT[(c8 * 8 + 4) * 72 + p] = (bf16_t)(w.z & 0xffff); VT[(c8 * 8 + 5) * 72 + p] = (bf16_t)(w.z >> 16); VT[(c8 * 8 + 6) * 72 + p] = (bf16_t)(w.w & 0xffff); VT[(c8 * 8 + 7) * 72 + p] = (bf16_t)(w.w >> 16); }
    LBAR();
#pragma unroll
    for (int q = 0; q < 4; ++q) { const int ch = tid + 512 * q, row = ch >> 3, cc = ch & 7; const u32x4 w = *(const LAS u32x4*)(VT + row * 72 + cc * 8);
        *(u32x4*)(SVT + ((size_t)(b * 4 + (row >> 6)) * 64 + (row & 63)) * SEQ + s0 + cc * 8) = w; }
    {
        f32x4 acc[4][3];
#pragma unroll
        for (int m = 0; m < 4; ++m)
#pragma unroll
            for (int nf = 0; nf < 3; ++nf) acc[m][nf] = (f32x4){0.f, 0.f, 0.f, 0.f};
#pragma unroll 2
        for (int kk = 0; kk < 8; ++kk) { bf16x8 a[4], bb[3];
#pragma unroll
            for (int m = 0; m < 4; ++m) a[m] = *(const LAS bf16x8*)(A1 + (16 * m + (lane & 15)) * 264 + kk * 32 + (lane >> 4) * 8);
#pragma unroll
            for (int nf = 0; nf < 3; ++nf) bb[nf] = *(const bf16x8*)(Wuq + (size_t)(16 * (3 * wid + nf) + (lane & 15)) * 256 + kk * 32 + (lane >> 4) * 8);
#pragma unroll
            for (int m = 0; m < 4; ++m)
#pragma unroll
                for (int nf = 0; nf < 3; ++nf) acc[m][nf] = MFMA16(a[m], bb[nf], acc[m][nf]); }
        const float SC = 0.10206207261596575f * 1.4426950408889634f;
#pragma unroll
        for (int m = 0; m < 4; ++m)
#pragma unroll
            for (int r = 0; r < 4; ++r) { const int t = 16 * m + 4 * (lane >> 4) + r;
                float v0 = acc[m][0][r], v1 = acc[m][1][r], v2 = acc[m][2][r];
                { const f32x2 cs = RT[(tok0 + t) * 16 + (lane & 15)]; const float y1 = v1 * cs[0] - v2 * cs[1], y2 = v2 * cs[0] + v1 * cs[1]; v1 = (wid & 1) ? y1 : v1; v2 = (wid & 1) ? y2 : v2; }
                LAS bf16_t* o = OUT + t * 392 + 48 * wid + (lane & 15);
                o[0] = f2bf(v0 * SC); o[16] = f2bf(v1 * SC); o[32] = f2bf(v2 * SC); }
    }
    LBAR();
#pragma unroll
    for (int q = 0; q < 6; ++q) { const int ch = tid + 512 * q, row = ch / 48, cc = ch % 48; const u32x4 w = *(const LAS u32x4*)(OUT + row * 392 + cc * 8);
        *(u32x4*)(MQ + (size_t)(tok0 + row) * 384 + cc * 8) = w; }
    LBAR();
    {   f32x4 acc[4][4];
#pragma unroll
        for (int m = 0; m < 4; ++m)
#pragma unroll
            for (int nf = 0; nf < 4; ++nf) acc[m][nf] = (f32x4){0.f, 0.f, 0.f, 0.f};
#pragma unroll 2
        for (int kk = 0; kk < 4; ++kk) { bf16x8 a[4], bb[4];
#pragma unroll
            for (int m = 0; m < 4; ++m) a[m] = *(const LAS bf16x8*)(A2 + (16 * m + (lane & 15)) * 136 + kk * 32 + (lane >> 4) * 8);
#pragma unroll
            for (int nf = 0; nf < 4; ++nf) bb[nf] = *(const bf16x8*)(Wukv + (size_t)(64 * wid + 16 * nf + (lane & 15)) * 128 + kk * 32 + (lane >> 4) * 8);
#pragma unroll
            for (int m = 0; m < 4; ++m)
#pragma unroll
                for (int nf = 0; nf < 4; ++nf) acc[m][nf] = MFMA16(a[m], bb[nf], acc[m][nf]); }
        const int hh = wid >> 1;
#pragma unroll
        for (int m = 0; m < 4; ++m)
#pragma unroll
            for (int r = 0; r < 4; ++r) { const int t = 16 * m + 4 * (lane >> 4) + r;
#pragma unroll
                for (int nf = 0; nf < 4; ++nf) { const bf16_t v = f2bf(acc[m][nf][r]);
                    if (wid & 1) VT[(hh * 64 + 16 * nf + (lane & 15)) * 72 + pos16(t)] = v; else OUT[t * 392 + hh * 96 + 16 * nf + (lane & 15)] = v; } }
    }
    LBAR();
#pragma unroll
    for (int q = 0; q < 4; ++q) { const int ch = tid + 512 * q, row = ch >> 5, hh = (ch >> 3) & 3, cc = ch & 7; const u32x4 w = *(const LAS u32x4*)(OUT + row * 392 + hh * 96 + cc * 8);
        *(u32x4*)(MK + (size_t)(tok0 + row) * 384 + hh * 96 + cc * 8) = w; }
#pragma unroll
    for (int q = 0; q < 4; ++q) { const int ch = tid + 512 * q, row = ch >> 3, cc = ch & 7; const u32x4 w = *(const LAS u32x4*)(VT + row * 72 + cc * 8);
        *(u32x4*)(MVT + ((size_t)(b * 4 + (row >> 6)) * 64 + (row & 63)) * SEQ + s0 + cc * 8) = w; }
}


constexpr int OT_OFF = 3 * GSLOT + 512;
DI void gdn_step(const Ctx& c, const int n, const int vt, const LAS unsigned char* lds0, f32x16& S0, f32x16& S1, const float gl, bf16_t* proj, const int b, const int h) {
    const int lane = c.lane, hi = lane >> 5;
    const LAS unsigned char* sl = lds0 + (n % 3) * GSLOT;
    bf16x8 sb[4]; sb[0] = pack8(S0, 0); sb[1] = pack8(S0, 1); sb[2] = pack8(S1, 0); sb[3] = pack8(S1, 1);
    f32x16 vn[2], o[2];
#pragma unroll
    for (int ct = 0; ct < 2; ++ct) { const u32x4 u0 = *(const LAS u32x4*)(sl + 4 * 8192 + ((ct * 2 + vt) * 64 + lane) * 32), u1 = *(const LAS u32x4*)(sl + 4 * 8192 + ((ct * 2 + vt) * 64 + lane) * 32 + 16);
        vn[ct][0] = bflo(u0.x); vn[ct][1] = bfhi(u0.x); vn[ct][2] = bflo(u0.y); vn[ct][3] = bfhi(u0.y); vn[ct][4] = bflo(u0.z); vn[ct][5] = bfhi(u0.z); vn[ct][6] = bflo(u0.w); vn[ct][7] = bfhi(u0.w);
        vn[ct][8] = bflo(u1.x); vn[ct][9] = bfhi(u1.x); vn[ct][10] = bflo(u1.y); vn[ct][11] = bfhi(u1.y); vn[ct][12] = bflo(u1.z); vn[ct][13] = bfhi(u1.z); vn[ct][14] = bflo(u1.w); vn[ct][15] = bfhi(u1.w);
#pragma unroll
        for (int r = 0; r < 16; ++r) o[ct][r] = 0.f; }
#define GFRAG(mat, mt, ks) (*(const LAS bf16x8*)(sl + (mat) * 8192 + (((mt) * 4 + (ks)) * 64 + lane) * 16))
#define GLOAD4(dst, mat, mt) do { _Pragma("unroll") for (int ks_ = 0; ks_ < 4; ++ks_) dst[ks_] = GFRAG(mat, mt, ks_); } while (0)
#define SCHEDB() __builtin_amdgcn_sched_barrier(0)
#define MMA4(acc, fr, bop) do { _Pragma("unroll") for (int ks_ = 0; ks_ < 4; ++ks_) acc = MFMA32(fr[ks_], bop[ks_], acc); } while (0)
#define MMA8(acc0, acc1, f0, f1, bop) do { _Pragma("unroll") for (int ks_ = 0; ks_ < 4; ++ks_) { acc0 = MFMA32(f0[ks_], bop[ks_], acc0); acc1 = MFMA32(f1[ks_], bop[ks_], acc1); } } while (0)
    bf16x8 fa[4], fb[4], fc[4], fd[4];
    GLOAD4(fa, 0, 0); GLOAD4(fb, 0, 1); GLOAD4(fc, 1, 0); GLOAD4(fd, 1, 1); SCHEDB();
    MMA8(vn[0], vn[1], fa, fb, sb); SCHEDB();
    GLOAD4(fa, 3, 0); GLOAD4(fb, 3, 1); SCHEDB();
    MMA8(o[0], o[1], fc, fd, sb); SCHEDB();
    GLOAD4(fc, 2, 0); GLOAD4(fd, 2, 1); SCHEDB();
    bf16x8 vb[4]; vb[0] = pack8(vn[0], 0); vb[1] = pack8(vn[0], 1); vb[2] = pack8(vn[1], 0); vb[3] = pack8(vn[1], 1);
#pragma unroll
    for (int r = 0; r < 16; ++r) { S0[r] *= gl; S1[r] *= gl; }
    SCHEDB();
    MMA8(S0, S1, fa, fb, vb);
    MMA8(o[0], o[1], fc, fd, vb);
#undef MMA8
#undef GLOAD4
#undef SCHEDB
#undef MMA4
#undef GFRAG
    LAS bf16_t* ot = (LAS bf16_t*)(lds0 + OT_OFF + (n & 1) * 9216) + crow(0, hi) * 72 + 32 * vt + (lane & 31);
#pragma unroll
    for (int ct = 0; ct < 2; ++ct)
#pragma unroll
        for (int r = 0; r < 16; ++r) ot[(32 * ct + (r & 3) + 8 * (r >> 2)) * 72] = f2bf(o[ct][r]);
}

DI void gdn_scan(const Ctx& c, int bh, const unsigned char* gbase, const float* GL, bf16_t* proj, const float* normw) {
    const int tid = c.tid, lane = c.lane, wid = c.wid, hi = lane >> 5;
    const int b = bh >> 3, h = bh & 7;
    const unsigned char* src = gbase + (size_t)bh * 64 * GSLOT;
    __syncthreads();
#pragma unroll
    for (int q = 0; q < 5; ++q) { *(LAS u32x4*)(c.lds + tid * 16 + q * 8192) = *(const u32x4*)(src + tid * 16 + q * 8192);
        *(LAS u32x4*)(c.lds + GSLOT + tid * 16 + q * 8192) = *(const u32x4*)(src + GSLOT + tid * 16 + q * 8192); }
    f32x16 S0, S1;
#pragma unroll
    for (int r = 0; r < 16; ++r) { S0[r] = 0.f; S1[r] = 0.f; }
    LAS float* glds = (LAS float*)(c.lds + 3 * GSLOT);
    if (tid < 64) glds[tid] = GL[bh * 64 + tid];
    LAS float* nwl = glds + 64; if (tid < 64) nwl[tid] = normw[tid];
    const int lw = wid - 2;
#define GDMA(chunk) do { if ((chunk) < 64) { const unsigned char* g_ = src + (size_t)(chunk) * GSLOT + (size_t)(lw * 64 + lane) * 16; LAS unsigned char* d_ = c.lds + ((chunk) % 3) * GSLOT + lw * 1024; \
        _Pragma("unroll") for (int p = 0; p < 10; ++p) __builtin_amdgcn_global_load_lds((const unsigned*)(g_ + p * 4096), (LAS unsigned*)(d_ + p * 4096), 16, 0, 0); } } while (0)
#define GHELP(chunk, ZR) do { const LAS unsigned char* tp_ = c.lds + OT_OFF + ((chunk) & 1) * 9216 + lane * 144; u32x4 ov_[8]; \
        _Pragma("unroll") for (int k = 0; k < 8; ++k) ov_[k] = *(const LAS u32x4*)(tp_ + k * 16); \
        float ss_ = 0.f; \
        _Pragma("unroll") for (int k = 0; k < 8; ++k) { ss_ += bflo(ov_[k].x) * bflo(ov_[k].x) + bfhi(ov_[k].x) * bfhi(ov_[k].x) + bflo(ov_[k].y) * bflo(ov_[k].y) + bfhi(ov_[k].y) * bfhi(ov_[k].y) \
            + bflo(ov_[k].z) * bflo(ov_[k].z) + bfhi(ov_[k].z) * bfhi(ov_[k].z) + bflo(ov_[k].w) * bflo(ov_[k].w) + bfhi(ov_[k].w) * bfhi(ov_[k].w); } \
        const float rs_ = __builtin_amdgcn_rsqf(ss_ * (1.f / 64.f) + 1e-6f); \
        bf16_t* op_ = proj + (size_t)(b * SEQ + (chunk) * 64 + lane) * NINP + h * 64 + 32 * hc; \
        _Pragma("unroll") for (int k = 0; k < 4; ++k) { const f32x4 n0_ = *(const LAS f32x4*)(nwl + 32 * hc + 8 * k) * rs_, n1_ = *(const LAS f32x4*)(nwl + 32 * hc + 8 * k + 4) * rs_; const u32x4 zv_ = ZR[k]; \
            const u32x4 oq_ = hc ? ov_[4 + k] : ov_[k]; u32x4 w_; \
            w_.x = pk2(bflo(oq_.x) * n0_[0] * silu_f(bflo(zv_.x)), bfhi(oq_.x) * n0_[1] * silu_f(bfhi(zv_.x))); w_.y = pk2(bflo(oq_.y) * n0_[2] * silu_f(bflo(zv_.y)), bfhi(oq_.y) * n0_[3] * silu_f(bfhi(zv_.y))); \
            w_.z = pk2(bflo(oq_.z) * n1_[0] * silu_f(bflo(zv_.z)), bfhi(oq_.z) * n1_[1] * silu_f(bfhi(zv_.z))); w_.w = pk2(bflo(oq_.w) * n1_[2] * silu_f(bflo(zv_.w)), bfhi(oq_.w) * n1_[3] * silu_f(bfhi(zv_.w))); \
            *(u32x4*)(op_ + 8 * k) = w_; } } while (0)
#define GZLOAD(ZR, chunk) do { const bf16_t* zp_ = proj + (size_t)(b * SEQ + (chunk) * 64 + lane) * NINP + C_GZ + h * 64 + 32 * hc; \
        _Pragma("unroll") for (int k = 0; k < 4; ++k) ZR[k] = *(const u32x4*)(zp_ + 8 * k); } while (0)
    if (wid >= 6) {
        const int hc = wid - 6;
        u32x4 zA[4], zB[4];
        GZLOAD(zA, 0);
        for (int n = 0; n < 64; n += 2) {
            LBAR(); if (n > 0) GHELP(n - 1, zB); GZLOAD(zB, n + 1);
            LBAR(); GHELP(n, zA); { const int nx = n + 2 < 64 ? n + 2 : 63; GZLOAD(zA, nx); }
        }
        LBAR();
        GHELP(63, zB);
    } else {
        if (wid >= 2) GDMA(2);
        const LAS unsigned char* sl_base = c.lds;
        for (int n = 0; n < 64; ++n) {
            if (wid >= 2) { if (n + 2 < 64 && n > 0) asm volatile("s_waitcnt vmcnt(10)" ::: "memory"); else asm volatile("s_waitcnt vmcnt(0)" ::: "memory"); }
            LBAR();
            if (wid >= 2) { if (n > 0) GDMA(n + 2); }
            else gdn_step(c, n, wid, sl_base, S0, S1, glds[n], proj, b, h);
        }
        LBAR();
    }
#undef GDMA
#undef GHELP
#undef GZLOAD
}

template <int MODE>
DI void attn_unit(const Ctx& c, int bh, int qb, const bf16_t* Qp, int qpitch, const bf16_t* Kp, int kpitch, const bf16_t* VTp, bf16_t* Op, int opitch) {
    constexpr int DQK = MODE ? 96 : 64, NKS = DQK / 16, KSTR = (DQK + 8) * 2, CPR = DQK / 8, KBYTES = 64 * KSTR;
    const int tid = c.tid, lane = c.lane, wid = c.wid, l31 = lane & 31, hi = lane >> 5;
    const int b = bh >> 2, hh = bh & 3; const size_t rowbase = (size_t)b * SEQ;
    const int q0 = qb * 256, qw0 = q0 + 32 * wid, NT = 4 * qb + 4;
    LAS unsigned char* KB = c.lds; LAS unsigned char* VB = c.lds + 2 * KBYTES; LAS bf16_t* OST = (LAS bf16_t*)(c.lds + 2 * KBYTES + 2 * 9216 + wid * 4608);
    const bf16_t* Kh = Kp + rowbase * kpitch + hh * DQK; const bf16_t* Vh = VTp + (size_t)(b * 4 + hh) * 64 * SEQ;
    bf16x8 qf[NKS];
#pragma unroll
    for (int ks = 0; ks < NKS; ++ks) qf[ks] = *(const bf16x8*)(Qp + (rowbase + qw0 + l31) * qpitch + hh * DQK + 16 * ks + 8 * hi);
    f32x16 o[2];
#pragma unroll
    for (int r = 0; r < 16; ++r) { o[0][r] = 0.f; o[1][r] = 0.f; }
    float mrun = -1e30f, lrun = 0.f, R = 0.f;
    bf16x8 uf[2];
    if (MODE == 0) {
#pragma unroll
        for (int s = 0; s < 2; ++s)
#pragma unroll
            for (int j = 0; j < 8; ++j) { const int k = 16 * s + 8 * (j >> 2) + 4 * hi + (j & 3); uf[s][j] = (k >= l31) ? (short)0x3F80 : (short)0; } }
    u32x4 pk_[2], pv_;
    const int krow0 = tid / CPR, kcc0 = tid % CPR, krow1 = ((tid & 255) + 512) / CPR, kcc1 = ((tid & 255) + 512) % CPR;
#define PREFETCH(t) do { const size_t kr_ = (size_t)64 * (t); pk_[0] = *(const u32x4*)(Kh + (kr_ + krow0) * kpitch + kcc0 * 8); \
        if (MODE == 1) pk_[1] = *(const u32x4*)(Kh + (kr_ + krow1) * kpitch + kcc1 * 8); \
        pv_ = *(const u32x4*)(Vh + (size_t)(tid >> 3) * SEQ + kr_ + (tid & 7) * 8); } while (0)
    int done = 0;
    PREFETCH(MODE ? 0 : NT - 1);
    for (int it = 0; it < NT; ++it) {
        const int t = MODE ? it : NT - 1 - it;
        LAS unsigned char* kb = KB + (it & 1) * KBYTES; LAS unsigned char* vbuf = VB + (it & 1) * 9216;
        *(LAS u32x4*)(kb + krow0 * KSTR + kcc0 * 16) = pk_[0];
        if (MODE == 1 && tid < 256) *(LAS u32x4*)(kb + krow1 * KSTR + kcc1 * 16) = pk_[1];
        *(LAS u32x4*)(vbuf + (tid >> 3) * 144 + (tid & 7) * 16) = pv_;
        if (MODE == 0) { if (__syncthreads_and(done)) break; } else __syncthreads();
        if (it + 1 < NT) PREFETCH(MODE ? it + 1 : NT - 2 - it);
#define KFRAG(sub, ks) (*(const LAS bf16x8*)(kb + (32 * (sub) + l31) * KSTR + (16 * (ks) + 8 * hi) * 2))
#define VFRAG(dt, sub, s2) (*(const LAS bf16x8*)(vbuf + (32 * (dt) + l31) * 144 + (32 * (sub) + 16 * (s2) + 8 * hi) * 2))
        if (MODE == 1) {
            if (64 * t <= qw0 + 31) {
                f32x16 s0, s1;
#pragma unroll
                for (int r = 0; r < 16; ++r) { s0[r] = 0.f; s1[r] = 0.f; }
                bf16x8 kf0[NKS], kf1[NKS], vf[8];
#pragma unroll
                for (int ks = 0; ks < NKS; ++ks) { kf0[ks] = KFRAG(0, ks); kf1[ks] = KFRAG(1, ks); }
                __builtin_amdgcn_sched_barrier(0);
#pragma unroll
                for (int ks = 0; ks < NKS; ++ks) { s0 = MFMA32(kf0[ks], qf[ks], s0); s1 = MFMA32(kf1[ks], qf[ks], s1); }
                __builtin_amdgcn_sched_barrier(0);
#pragma unroll
                for (int dt = 0; dt < 2; ++dt) { vf[dt * 4 + 0] = VFRAG(dt, 0, 0); vf[dt * 4 + 1] = VFRAG(dt, 0, 1); vf[dt * 4 + 2] = VFRAG(dt, 1, 0); vf[dt * 4 + 3] = VFRAG(dt, 1, 1); }
                __builtin_amdgcn_sched_barrier(0);
                if (64 * t + 63 > qw0) { const int q = qw0 + l31;
#pragma unroll
                    for (int r = 0; r < 16; ++r) { const int key = 64 * t + crow(r, hi); if (key > q) s0[r] = -INFINITY; if (key + 32 > q) s1[r] = -INFINITY; } }
                float mx = fmaxf(s0[0], s1[0]);
#pragma unroll
                for (int r = 1; r < 16; ++r) mx = fmaxf(mx, fmaxf(s0[r], s1[r]));
                mx = half_max(mx);
                if (__any(mx > mrun)) {
                    const float mn_ = fmaxf(mrun, mx), al = fexp2(mrun - mn_); mrun = mn_; lrun *= al;
#pragma unroll
                    for (int r = 0; r < 16; ++r) { o[0][r] *= al; o[1][r] *= al; } }
                const float mn = mrun;
                float ls = 0.f;
#pragma unroll
                for (int r = 0; r < 16; ++r) { s0[r] = fexp2(s0[r] - mn); s1[r] = fexp2(s1[r] - mn); ls += s0[r] + s1[r]; }
                lrun += ls;
                const bf16x8 p0 = pack8(s0, 0), p1 = pack8(s0, 1), p2 = pack8(s1, 0), p3 = pack8(s1, 1);
#pragma unroll
                for (int dt = 0; dt < 1; ++dt) { o[0] = MFMA32(vf[0], p0, o[0]); o[1] = MFMA32(vf[4], p0, o[1]); o[0] = MFMA32(vf[1], p1, o[0]); o[1] = MFMA32(vf[5], p1, o[1]);
                    o[0] = MFMA32(vf[2], p2, o[0]); o[1] = MFMA32(vf[6], p2, o[1]); o[0] = MFMA32(vf[3], p3, o[0]); o[1] = MFMA32(vf[7], p3, o[1]); }
            }
        } else {
            const float C2 = 0.125f * 1.4426950408889634f;
#pragma unroll
            for (int sub = 1; sub >= 0; --sub) {
                const int kbase = 64 * t + 32 * sub;
                if (kbase < qw0 + 31) {
                    f32x16 s;
#pragma unroll
                    for (int r = 0; r < 16; ++r) s[r] = 0.f;
                    bf16x8 kfs[NKS], vfs[4];
#pragma unroll
                    for (int ks = 0; ks < NKS; ++ks) kfs[ks] = KFRAG(sub, ks);
                    __builtin_amdgcn_sched_barrier(0);
#pragma unroll
                    for (int ks = 0; ks < NKS; ++ks) s = MFMA32(kfs[ks], qf[ks], s);
                    __builtin_amdgcn_sched_barrier(0);
                    vfs[0] = VFRAG(0, sub, 0); vfs[1] = VFRAG(0, sub, 1); vfs[2] = VFRAG(1, sub, 0); vfs[3] = VFRAG(1, sub, 1);
                    __builtin_amdgcn_sched_barrier(0);
                    const bool need_mask = (kbase + 31 >= qw0); const int q = qw0 + l31;
                    f32x16 lm, rin; float rsum = 0.f;
#pragma unroll
                    for (int r = 0; r < 16; ++r) { const float z2 = s[r] * C2; const float e = fexp2(-fabsf(z2)); float v = -(fmaxf(z2, 0.f) + flog2(1.f + e));
                        const bool valid = !need_mask || (kbase + crow(r, hi) < q);
                        v = valid ? v : 0.f; lm[r] = v; s[r] = valid ? z2 : -INFINITY; rsum += v; rin[r] = R; }
                    f32x16 lo;
                    const bf16x8 h0 = pack8(lm, 0), h1 = pack8(lm, 1);
#pragma unroll
                    for (int r = 0; r < 8; ++r) { lo[r] = lm[r] - __uint_as_float(((unsigned)(unsigned short)h0[r]) << 16); lo[8 + r] = lm[8 + r] - __uint_as_float(((unsigned)(unsigned short)h1[r]) << 16); }
                    const bf16x8 l0 = pack8(lo, 0), l1 = pack8(lo, 1);
                    f32x16 cum = MFMA32(uf[0], h0, rin); cum = MFMA32(uf[1], h1, cum); cum = MFMA32(uf[0], l0, cum); cum = MFMA32(uf[1], l1, cum);
                    rsum = half_sum(rsum); R += rsum;
#pragma unroll
                    for (int r = 0; r < 16; ++r) s[r] = fexp2(s[r] + cum[r]);
                    const bf16x8 p0 = pack8(s, 0), p1 = pack8(s, 1);
#pragma unroll
                    for (int dt = 0; dt < 1; ++dt) { o[0] = MFMA32(vfs[0], p0, o[0]); o[1] = MFMA32(vfs[2], p0, o[1]); o[0] = MFMA32(vfs[1], p1, o[0]); o[1] = MFMA32(vfs[3], p1, o[1]); }
                }
            }
            done = __all(R < -152.0f) ? 1 : 0;
        }
#undef KFRAG
#undef VFRAG
    }
#undef PREFETCH
    float inv = 1.f;
    if (MODE == 1) { lrun = half_sum(lrun); inv = 1.f / lrun; }
#pragma unroll
    for (int dt = 0; dt < 2; ++dt)
#pragma unroll
        for (int r = 0; r < 16; ++r) OST[l31 * 72 + 32 * dt + crow(r, hi)] = f2bf(o[dt][r] * inv);
    asm volatile("s_waitcnt lgkmcnt(0)" ::: "memory");
#pragma unroll
    for (int i = 0; i < 4; ++i) { const int row = i * 8 + (lane >> 3), ch = lane & 7; const u32x4 v = *(const LAS u32x4*)(OST + row * 72 + ch * 8);
        *(u32x4*)(Op + (rowbase + qw0 + row) * opitch + hh * 64 + ch * 8) = v; }
    __syncthreads();
}


#define XB_TMO      128
#define XB_XCNT(j)  (256  + 64 * (j))
#define XB_XSUB(j)  (1280 + 64 * (j))
#define XB_XGEN(j)  (2304 + 64 * (j))
#define XB_TOP      3328
#define XB_TOPGEN   3392
#define XB_SPIN_CAP (1u << 22)
DI unsigned xb_ld(unsigned* p)              { return __hip_atomic_load(p, __ATOMIC_RELAXED, __HIP_MEMORY_SCOPE_AGENT); }
DI unsigned xb_add(unsigned* p, unsigned v) { return __hip_atomic_fetch_add(p, v, __ATOMIC_RELAXED, __HIP_MEMORY_SCOPE_AGENT); }
DI unsigned xb_xcc_id() { return (unsigned)__builtin_amdgcn_s_getreg((3 << 11) | 20) & 0xFu; }
#define XB_SPIN(cond, bar) do { unsigned _sp = 0; while (cond) { __builtin_amdgcn_s_sleep(1); \
    if ((++_sp & 255u) == 0u) { if (xb_ld(&(bar)[XB_TMO])) break; if (_sp > XB_SPIN_CAP) { atomicAdd(&(bar)[XB_TMO], 1u); break; } } } } while (0)
struct XcdBarrier { unsigned* bar; unsigned x; volatile LAS unsigned* st; };
DI XcdBarrier xcd_barrier_post(unsigned* bar, volatile LAS unsigned* st, bool post) {
    XcdBarrier b; b.bar = bar; b.x = xb_xcc_id(); b.st = st;
    if (post && threadIdx.x == 0) (void)xb_add(&bar[XB_XCNT(b.x)], 1u);
    return b;
}
DI void xcd_barrier_complete(unsigned* bar, unsigned x, unsigned& nloc, unsigned& nx) {
    const unsigned G = gridDim.x * gridDim.y * gridDim.z;
    unsigned sum, cnt, mine, sp = 0u;
    for (;;) {
        sum = 0u; cnt = 0u; mine = 0u;
#pragma unroll
        for (unsigned j = 0; j < 16; ++j) { const unsigned cc = xb_ld(&bar[XB_XCNT(j)]); sum += cc; cnt += (cc > 0u) ? 1u : 0u; mine = (j == x) ? cc : mine; }
        if (sum == G) break;
        __builtin_amdgcn_s_sleep(1);
        if ((++sp & 255u) == 0u) { if (xb_ld(&bar[XB_TMO])) break; if (sp > XB_SPIN_CAP) { atomicAdd(&bar[XB_TMO], 1u); break; } }
    }
    nloc = mine > 0u ? mine : 1u; nx = cnt > 0u ? cnt : 1u;
}
DI void xcd_barrier(const XcdBarrier& b) {
    asm volatile("s_waitcnt vmcnt(0)" ::: "memory");
    __syncthreads();
    if (threadIdx.x == 0) {
        unsigned* bar = b.bar;
        __builtin_amdgcn_s_waitcnt(0);
        unsigned nloc = b.st[0], nx = b.st[1];
        if (nloc == 0u) { xcd_barrier_complete(bar, b.x, nloc, nx); b.st[0] = nloc; b.st[1] = nx; }
        const unsigned old = xb_add(&bar[XB_XSUB(b.x)], 1u);
        const unsigned gen = old / nloc;
        if (old + 1u == (gen + 1u) * nloc) {
            __builtin_amdgcn_fence(__ATOMIC_RELEASE, "agent");
            asm volatile("s_waitcnt vmcnt(0)" ::: "memory");
            const unsigned og = xb_add(&bar[XB_TOP], 1u);
            const unsigned tg = og / nx;
            if (og + 1u == (tg + 1u) * nx) xb_add(&bar[XB_TOPGEN], 1u);
            else XB_SPIN(xb_ld(&bar[XB_TOPGEN]) == tg, bar);
            __builtin_amdgcn_fence(__ATOMIC_ACQUIRE, "agent");
            xb_add(&bar[XB_XGEN(b.x)], 1u);
            asm volatile("s_waitcnt vmcnt(0)" ::: "memory");
        } else {
            XB_SPIN(xb_ld(&bar[XB_XGEN(b.x)]) == gen, bar);
            __builtin_amdgcn_fence(__ATOMIC_ACQUIRE, "agent");
            asm volatile("s_waitcnt vmcnt(0)" ::: "memory");
        }
    }
    __syncthreads();
}

struct Args { const float* in[21]; float* out; unsigned char* ws; int ph_lo, ph_hi, rep, pad; };
constexpr int NPHASE = 27;

template <int SP> DI void do_phase(const Ctx& c, const Args& args, const int l, const int rep = 0) {
    unsigned char* ws = args.ws;
    bf16_t* W = (bf16_t*)(ws + WS_W); bf16_t* AB = (bf16_t*)(ws + WS_AB); bf16_t* HB0 = (bf16_t*)(ws + WS_G); bf16_t* HB1 = (bf16_t*)(ws + WS_HB1);
    float* H = args.out;
    const float* ln_g = args.in[17] + (size_t)l * 3 * DM; const float* ln_b = args.in[18] + (size_t)l * 3 * DM;
    LayerW L; L.a1 = args.in[3] + (size_t)l * 1024 * 5632; L.a2 = args.in[4] + (size_t)l * 2816 * 1024; L.mi = args.in[5] + (size_t)l * 1024 * NIN; L.uq = args.in[12] + (size_t)l * 256 * 384;
    L.ukv = args.in[13] + (size_t)l * 128 * 512; L.wo = args.in[14] + (size_t)l * 1024 * 1024; L.b1 = args.in[15] + (size_t)l * 1024 * 5632; L.b2 = args.in[16] + (size_t)l * 2816 * 1024;
    L.gt = args.in[19] + (size_t)l * 1024 * 1024; L.pp = args.in[20] + (size_t)l * 256 * 1024;
    if constexpr (SP == 0) {
        if (l == 0) { cvt_phase(c, args.in[0], HB0, nullptr, (size_t)T_ * DM); rope_phase(c, (const int*)args.in[2], (f32x2*)(ws + WS_ROPE)); }
        conv_phase<0>(c, L, W, c.bid * 8 + c.wid, c.G * 8); }
    else if constexpr (SP == 1 || SP == 9) { pg8::Gemm g{SP == 1 ? (l == 0 ? HB0 : HB1) : HB0, W + (SP == 1 ? OW_A1 : OW_B1), T_, 5632, 1024, 1024}; pg8::StaticOrder S; S.init(T_, 5632, c.G, c.bid);
        pg8::EpiSwiGLU E{AB, DFF}; pg8::gemm_phase<pg8::EpiSwiGLU, pg8::StaticOrder, true>(c.lds, g, S, E);
        if (c.G == 256 && c.bid >= 128) {
            if constexpr (SP == 1) conv_phase<1>(c, L, W, (c.bid - 128) * 8 + c.wid, 128 * 8);
            else { pg8::Gemm g2{(const bf16_t*)(ws + WS_SVT), W + OW_P, T_, 1024, 256, 256}; pg8::StaticOrder S2; S2.init(T_, 1024, 128, c.bid - 128);
                pg8::EpiBf16 E2{(bf16_t*)(ws + WS_MQ), DM}; pg8::gemm_phase<pg8::EpiBf16, pg8::StaticOrder, true>(c.lds, g2, S2, E2); }
        } else if (c.G != 256) {
            if constexpr (SP == 1) conv_phase<1>(c, L, W, c.bid * 8 + c.wid, c.G * 8);
            else { pg8::Gemm g2{(const bf16_t*)(ws + WS_SVT), W + OW_P, T_, 1024, 256, 256}; pg8::StaticOrder S2; S2.init(T_, 1024, c.G, c.bid);
                pg8::EpiBf16 E2{(bf16_t*)(ws + WS_MQ), DM}; pg8::gemm_phase<pg8::EpiBf16, pg8::StaticOrder, true>(c.lds, g2, S2, E2); }
        } }
    else if constexpr (SP == 2 || SP == 10) { pg8::Gemm g{AB, W + (SP == 2 ? OW_A2 : OW_B2), T_, 1024, DFF, DFF}; pg8::StaticOrder S; S.init(T_, 1024, c.G, c.bid);
        pg8::EpiResidLn E{(SP == 2 && l == 0) ? args.in[0] : H, H, HB0, DM, ALPHA, 0.5f, ln_g + (SP == 2 ? 0 : 2 * DM), ln_b + (SP == 2 ? 0 : 2 * DM),
                          (unsigned long long*)(ws + WS_CTL + 524288), (unsigned*)(ws + WS_CTL + 131072) + (l * 3 + (SP == 2 ? 0 : 2)) * 4096};
        pg8::gemm_phase<pg8::EpiResidLn, pg8::StaticOrder, false>(c.lds, g, S, E); }
    else if constexpr (SP == 3) ln_phase(c, H, HB0, ln_g, ln_b);
    else if constexpr (SP == 4) { pg8::Gemm g{HB0, W + OW_MI, T_, NINP, 1024, 1024}; pg8::StaticOrder S; S.init(T_, NINP, c.G, c.bid);
        pg8::EpiBf16 E{AB, NINP}; pg8::gemm_phase<pg8::EpiBf16, pg8::StaticOrder, true>(c.lds, g, S, E);
        LayerW Ln; Ln.a1 = args.in[3] + (size_t)1 * 1024 * 5632; Ln.a2 = args.in[4] + (size_t)1 * 2816 * 1024; Ln.mi = Ln.uq = Ln.ukv = Ln.wo = Ln.b1 = Ln.b2 = Ln.gt = Ln.pp = nullptr;
        if (c.G == 256) { if (c.bid >= 64) { conv_phase<2>(c, L, W, (c.bid - 64) * 8 + c.wid, 192 * 8); if (l == 0) conv_phase<0>(c, Ln, W, (c.bid - 64) * 8 + c.wid, 192 * 8); } }
        else { conv_phase<2>(c, L, W, c.bid * 8 + c.wid, c.G * 8); if (l == 0) conv_phase<0>(c, Ln, W, c.bid * 8 + c.wid, c.G * 8); } }
    else if constexpr (SP == 5) {
        float* GL = (float*)(ws + WS_GL); const f32x2* RT = (const f32x2*)(ws + WS_ROPE);
        if (rep != 2) { u32x4 gx[12]; bf16_t gga = 0, ggb = 0;
            if (c.bid < 2048) gdn_prefetch(c, c.bid, AB, gx, gga, ggb);
            for (int it = c.bid; it < 2048; it += c.G) gdn_prep_item(c, it, it + c.G < 2048 ? it + c.G : it, gx, gga, ggb, AB, args.in[6] + (size_t)l * 4 * 1536, args.in[7] + l * 8, args.in[8] + l * 8, ws + WS_G, GL, rep); }
        if (rep != 1) for (int it = c.bid; it < 256; it += c.G) mla_prep_item(c, it, AB, args.in[10] + l * 256, args.in[11] + l * 128, W + OW_UQ, W + OW_UKV, RT, (bf16_t*)(ws + WS_MQ), (bf16_t*)(ws + WS_MK), (bf16_t*)(ws + WS_MVT), (bf16_t*)(ws + WS_SVT));
    }
    else if constexpr (SP == 6) {
        unsigned* ctl = (unsigned*)(ws + WS_CTL); const float* GL = (const float*)(ws + WS_GL);
        LAS unsigned* qword = (LAS unsigned*)(c.lds + 147000);
#ifndef NO_SCAN
        if (rep != 2) for (int g = c.bid; g < 32; g += c.G) gdn_scan(c, g, ws + WS_G, GL, AB, args.in[9] + l * 64);
#endif
#ifndef NO_ATTN
        if (rep != 1) for (;;) {
            __syncthreads();
            if (c.tid == 0) *qword = atomicAdd(ctl + 64 * (1 + l + 2 * rep), 1u);
            __syncthreads();
            const unsigned u = *qword;
            if (u >= 512u) break;
            const int bh = u & 15, qb = 15 - ((u >> 4) & 15);
            if (u < 256u) attn_unit<1>(c, bh, qb, (const bf16_t*)(ws + WS_MQ), 384, (const bf16_t*)(ws + WS_MK), 384, (const bf16_t*)(ws + WS_MVT), AB + 768, NINP);
#ifndef NO_SB
            else attn_unit<0>(c, bh, qb, AB + C_SQ, NINP, AB + C_SK, NINP, (const bf16_t*)(ws + WS_SVT), AB + 512, NINP);
#endif
        }
#endif
    }
    else if constexpr (SP == 7) { pg8::Gemm g{AB, W + OW_O, T_, 1024, 1024, NINP}; pg8::StaticOrder S; S.init(T_, 1024, c.G, c.bid);
        pg8::EpiResidLn E{H, H, HB0, DM, ALPHA, 1.0f, ln_g + DM, ln_b + DM, (unsigned long long*)(ws + WS_CTL + 524288), (unsigned*)(ws + WS_CTL + 131072) + (l * 3 + 1) * 4096};
        pg8::gemm_phase<pg8::EpiResidLn, pg8::StaticOrder, false>(c.lds, g, S, E);
        cvt_phase(c, args.in[1] + (size_t)l * T_ * 256, (bf16_t*)(ws + WS_SVT), nullptr, (size_t)T_ * 256); }
    else if constexpr (SP == 8) { ln_phase(c, H, HB0, ln_g + DM, ln_b + DM); cvt_phase(c, args.in[1] + (size_t)l * T_ * 256, (bf16_t*)(ws + WS_PB), nullptr, (size_t)T_ * 256); }
    else if constexpr (SP == 11) { pg8::Gemm g{(const bf16_t*)(ws + WS_SVT), W + OW_P, T_, 1024, 256, 256}; pg8::StaticOrder S; S.init(T_, 1024, c.G, c.bid);
        pg8::EpiBf16 E{(bf16_t*)(ws + WS_MQ), DM}; pg8::gemm_phase<pg8::EpiBf16, pg8::StaticOrder, true>(c.lds, g, S, E); }
    else if constexpr (SP == 12) { pg8::Gemm g{HB0, W + OW_GT, T_, 1024, 1024, 1024}; pg8::StaticOrder S; S.init(T_, 1024, c.G, c.bid);
        pg8::EpiPle E{H, (const bf16_t*)(ws + WS_MQ), HB1, DM}; pg8::gemm_phase<pg8::EpiPle, pg8::StaticOrder, true>(c.lds, g, S, E); }
}

#ifndef SPMASK
#define SPMASK 0x16f7
#endif
#ifndef PROBE_REP
#define PROBE_REP 1
#endif
#ifndef PROBE_SPMASK
#define PROBE_SPMASK 0
#endif
__global__ void __launch_bounds__(512, 2) mk_fwd(Args args) {
    extern __shared__ __attribute__((aligned(16))) unsigned char lds_raw[];
    Ctx c; c.lds = (LAS unsigned char*)lds_raw; c.tid = threadIdx.x; c.lane = c.tid & 63; c.wid = __builtin_amdgcn_readfirstlane(c.tid >> 6); c.G = gridDim.x; c.bid = blockIdx.x;
    cg::grid_group grid = cg::this_grid();
    const int lo = args.ph_lo, hi = args.ph_hi;
    volatile LAS unsigned* xst = (volatile LAS unsigned*)(c.lds + 147008);
    if (c.tid == 0) { xst[0] = 0u; xst[1] = 0u; }
    __syncthreads();
    const XcdBarrier xbar = xcd_barrier_post((unsigned*)(args.ws + WS_CTL) + 1024, xst, hi - lo > 1);
    if (lo < 0) grid.sync();
#define SEAM(idx) if ((idx) > lo && (idx) > 1) { xcd_barrier(xbar); }
#define PH(L, SP) if (((SPMASK >> SP) & 1) && lo <= 1 + 13 * L + SP && 1 + 13 * L + SP < hi) { SEAM(1 + 13 * L + SP) do_phase<SP>(c, args, L, args.rep); }
    PH(0, 0) PH(0, 1) PH(0, 2) PH(0, 3) PH(0, 4) PH(0, 5) PH(0, 6) PH(0, 7) PH(0, 8) PH(0, 9) PH(0, 10) PH(0, 11) PH(0, 12)
      PH(1, 1) PH(1, 2) PH(1, 3) PH(1, 4) PH(1, 5) PH(1, 6) PH(1, 7) PH(1, 8) PH(1, 9) PH(1, 10) PH(1, 11) PH(1, 12)
#undef PH
#undef SEAM
}

extern "C" void kernel_launch(void* const* d_in, const int* in_sizes, int n_in, void* d_out, int out_size, void* d_ws, size_t ws_size, hipStream_t stream) {
    static int grid = 0;
    if (grid == 0) {
        if (n_in != 21 || out_size != T_ * DM || ws_size < WS_END) { fprintf(stderr, "kernel_launch: unexpected shapes (n_in %d out %d ws %zu)\n", n_in, out_size, ws_size); grid = -1; return; }
        int dev = 0, cus = 0, per_cu = 0;
        hipGetDevice(&dev); hipDeviceGetAttribute(&cus, hipDeviceAttributeMultiprocessorCount, dev);
        if (hipFuncSetAttribute((const void*)mk_fwd, hipFuncAttributeMaxDynamicSharedMemorySize, LDS_BYTES) != hipSuccess) { fprintf(stderr, "kernel_launch: hipFuncSetAttribute failed\n"); grid = -1; return; }
        if (hipOccupancyMaxActiveBlocksPerMultiprocessor(&per_cu, (const void*)mk_fwd, 512, LDS_BYTES) != hipSuccess || per_cu < 1) { fprintf(stderr, "kernel_launch: occupancy query %d\n", per_cu); per_cu = 1; }
        (void)hipGetLastError();
        grid = cus * 1;
    }
    if (grid < 0) return;
    hipMemsetAsync((char*)d_ws + WS_CTL, 0, 262144, stream);
    Args a{};
    for (int i = 0; i < 21; ++i) a.in[i] = (const float*)d_in[i];
    a.out = (float*)d_out; a.ws = (unsigned char*)d_ws;
#if MK_ONE_LAUNCH
    a.ph_lo = 0; a.ph_hi = NPHASE;
    void* kargs[] = {&a};
    hipError_t e = hipLaunchCooperativeKernel((const void*)mk_fwd, dim3(grid), dim3(512), kargs, LDS_BYTES, stream);
    if (e != hipSuccess) fprintf(stderr, "cooperative launch failed: %s (grid %d)\n", hipGetErrorString(e), grid);
#else
    for (int ph = 0; ph < NPHASE; ++ph) { a.ph_lo = ph; a.ph_hi = ph + 1; a.rep = 0; hipLaunchKernelGGL(mk_fwd, dim3(grid), dim3(512), LDS_BYTES, stream, a);
        if (ph >= 1 && ((PROBE_SPMASK >> ((ph - 1) % 13)) & 1)) { a.rep = PROBE_REP; hipLaunchKernelGGL(mk_fwd, dim3(grid), dim3(512), LDS_BYTES, stream, a); } }
#endif
}
```
